# Optimizing an MI355X kernel written in HIP

```python
import jax, jax.numpy as jnp
from jax import lax
import numpy as np

D_MODEL = 1024
BATCH = 4
SEQ = 4096
DEPTH = 2

GRID_W = 64
CTX_LEN = 256
HEAD_DIM = 64
NA_HEADS = 8
NA_WIDTH = NA_HEADS * HEAD_DIM
WIN_R = 8
WIN_C = 16
GQA_Q_HEADS = 8
GQA_KV_HEADS = 2
GQA_GROUP = GQA_Q_HEADS // GQA_KV_HEADS
GQA_WIDTH = GQA_Q_HEADS * HEAD_DIM
GQA_KV_WIDTH = GQA_KV_HEADS * HEAD_DIM
Q_BLOCK = 128
ROPE_THETA = 10000.0
ROT_AXIS = HEAD_DIM // 2
EPS = 1e-6
SPLIT_SIZES = (NA_WIDTH, NA_WIDTH, GQA_KV_WIDTH, GQA_KV_WIDTH,
               NA_WIDTH, GQA_WIDTH, NA_WIDTH, GQA_WIDTH, D_MODEL, D_MODEL)
KV_COLS = 2 * NA_WIDTH + 2 * GQA_KV_WIDTH
IN_COLS = sum(SPLIT_SIZES)

kernel_name = "hybrid_na_gqa_prefix_dit"


def _split(p, sizes):
    outs, off = [], 0
    for s in sizes:
        outs.append(p[..., off:off + s])
        off += s
    return outs


def _rmsnorm(x, g):
    xf = x.astype(jnp.float32)
    y = xf * lax.rsqrt(jnp.mean(xf * xf, axis=-1, keepdims=True) + EPS)
    return (y * g.astype(jnp.float32)).astype(x.dtype)


def _rope_axis(x, pos):
    half = ROT_AXIS // 2
    inv = 1.0 / (ROPE_THETA ** (jnp.arange(half, dtype=jnp.float32) / half))
    ang = pos.astype(jnp.float32)[:, None] * inv[None, :]
    cos = jnp.cos(ang)[None, :, None, :].astype(x.dtype)
    sin = jnp.sin(ang)[None, :, None, :].astype(x.dtype)
    x1, x2 = x[..., :half], x[..., half:]
    return jnp.concatenate([x1 * cos - x2 * sin, x2 * cos + x1 * sin], axis=-1)


def _rope_2d(x, pos_row, pos_col):
    return jnp.concatenate([_rope_axis(x[..., :ROT_AXIS], pos_row),
                            _rope_axis(x[..., ROT_AXIS:], pos_col)], axis=-1)


def _attend(q, k, v):
    s = jnp.einsum('bqkgd,btkd->bkgqt', q, k).astype(jnp.float32) * (HEAD_DIM ** -0.5)
    p = jax.nn.softmax(s, axis=-1).astype(v.dtype)
    return jnp.einsum('bkgqt,btkd->bqkgd', p, v)


def _na_latent(q, k, v, kc, vc, rpb, rows):
    B = q.shape[0]
    wr = min(WIN_R, rows)
    qg = q.reshape(B, rows, GRID_W, NA_HEADS, HEAD_DIM)
    kg = k.reshape(B, rows, GRID_W, NA_HEADS, HEAD_DIM)
    vg = v.reshape(B, rows, GRID_W, NA_HEADS, HEAD_DIM)
    cols = np.arange(GRID_W)
    cs = np.clip(cols - WIN_C // 2, 0, GRID_W - WIN_C)
    col_idx_np = (cs[:, None] + np.arange(WIN_C)[None, :]).astype(np.int32)
    col_off_np = (col_idx_np - cols[:, None] + (WIN_C - 1)).astype(np.int32)
    rws = np.arange(rows)
    rs = np.clip(rws - wr // 2, 0, rows - wr)
    row_idx_np = (rs[:, None] + np.arange(wr)[None, :]).astype(np.int32)
    row_off_np = (row_idx_np - rws[:, None] + (WIN_R - 1)).astype(np.int32)
    col_idx = jnp.asarray(col_idx_np)
    bias_all = rpb[:, row_off_np[:, :, None, None], col_off_np[None, None, :, :]]
    bias_all = jnp.transpose(bias_all, (1, 0, 3, 2, 4)).astype(jnp.float32)
    q_rows = jnp.transpose(qg, (1, 0, 2, 3, 4))
    scale = HEAD_DIM ** -0.5

    def row_block(args):
        qr, ridx, bias = args
        kb = jnp.take(kg, ridx, axis=1)
        vb = jnp.take(vg, ridx, axis=1)
        kw = jnp.take(kb, col_idx, axis=2)
        vw = jnp.take(vb, col_idx, axis=2)
        s_win = jnp.einsum('bchd,bicjhd->bhcij', qr, kw).astype(jnp.float32) * scale + bias[None]
        s_ctx = jnp.einsum('bchd,blhd->bhcl', qr, kc).astype(jnp.float32) * scale
        s = jnp.concatenate([s_win.reshape(B, NA_HEADS, GRID_W, wr * WIN_C), s_ctx], axis=-1)
        p = jax.nn.softmax(s, axis=-1).astype(v.dtype)
        p_win = p[..., :wr * WIN_C].reshape(B, NA_HEADS, GRID_W, wr, WIN_C)
        p_ctx = p[..., wr * WIN_C:]
        return (jnp.einsum('bhcij,bicjhd->bchd', p_win, vw)
                + jnp.einsum('bhcl,blhd->bchd', p_ctx, vc))

    out = lax.map(row_block, (q_rows, jnp.asarray(row_idx_np), bias_all))
    return jnp.transpose(out, (1, 0, 2, 3, 4)).reshape(B, rows * GRID_W, NA_WIDTH)


def _gqa_latent(q, k_all, v_all):
    B, S = q.shape[0], q.shape[1]
    nb = S // Q_BLOCK
    qb = q.reshape(B, nb, Q_BLOCK, GQA_KV_HEADS, GQA_GROUP, HEAD_DIM)
    qb = jnp.transpose(qb, (1, 0, 2, 3, 4, 5))
    out = lax.map(lambda qq: _attend(qq, k_all, v_all), qb)
    return jnp.transpose(out, (1, 0, 2, 3, 4, 5)).reshape(B, S, GQA_WIDTH)


def _merge(a_att, b_att, a_z, b_z, g_a, g_b, w_o_a, w_o_b, w_out):
    o_a = (a_att * jax.nn.silu(a_z)) @ w_o_a
    o_b = (b_att * jax.nn.silu(b_z)) @ w_o_b
    merged = jax.nn.sigmoid(g_a) * o_a + jax.nn.sigmoid(g_b) * o_b
    return merged @ w_out


def _layer(x, ctx, c, c_ctx, w_ada, b_ada, norm_g, w_in, q_norm_a, k_norm_a,
           q_norm_b, k_norm_b, rpb, w_o_a, w_o_b, w_out, pos_row, pos_col, update_ctx):
    B, S, _ = x.shape
    L = ctx.shape[1]
    rows = S // GRID_W
    mod_x = jax.nn.silu(c) @ w_ada + b_ada
    shift_x, scale_x, gate_x = jnp.split(mod_x[:, None, :], 3, axis=-1)
    mod_c = jax.nn.silu(c_ctx) @ w_ada + b_ada
    shift_c, scale_c, gate_c = jnp.split(mod_c, 3)
    hx = _rmsnorm(x, norm_g) * (1.0 + scale_x) + shift_x
    hc = _rmsnorm(ctx, norm_g) * (1.0 + scale_c) + shift_c

    px = hx @ w_in
    a_k, a_v, b_k, b_v, a_q, b_q, a_z, b_z, g_a, g_b = _split(px, SPLIT_SIZES)
    pc = hc @ (w_in if update_ctx else w_in[:, :KV_COLS])
    ca_k, ca_v, cb_k, cb_v = _split(pc[..., :KV_COLS], SPLIT_SIZES[:4])

    hs = lambda t, h: t.reshape(t.shape[0], t.shape[1], h, HEAD_DIM)
    qa = _rmsnorm(hs(a_q, NA_HEADS), q_norm_a)
    ka = _rmsnorm(hs(a_k, NA_HEADS), k_norm_a)
    va = hs(a_v, NA_HEADS)
    cka = _rmsnorm(hs(ca_k, NA_HEADS), k_norm_a)
    cva = hs(ca_v, NA_HEADS)
    a_att = _na_latent(qa, ka, va, cka, cva, rpb, rows)

    qb = _rope_2d(_rmsnorm(hs(b_q, GQA_Q_HEADS), q_norm_b), pos_row, pos_col)
    kb = _rope_2d(_rmsnorm(hs(b_k, GQA_KV_HEADS), k_norm_b), pos_row, pos_col)
    vb = hs(b_v, GQA_KV_HEADS)
    ckb = _rmsnorm(hs(cb_k, GQA_KV_HEADS), k_norm_b)
    cvb = hs(cb_v, GQA_KV_HEADS)
    k_all = jnp.concatenate([ckb, kb], axis=1)
    v_all = jnp.concatenate([cvb, vb], axis=1)
    b_att = _gqa_latent(qb, k_all, v_all)

    out_x = _merge(a_att, b_att, a_z, b_z, g_a, g_b, w_o_a, w_o_b, w_out)
    x_new = x + gate_x * out_x

    if update_ctx:
        _, _, _, _, c_aq, c_bq, c_az, c_bz, c_ga, c_gb = _split(pc, SPLIT_SIZES)
        cqa = _rmsnorm(hs(c_aq, NA_HEADS), q_norm_a)[:, :, :, None, :]
        c_a_att = _attend(cqa, cka, cva).reshape(B, L, NA_WIDTH)
        cqb = _rmsnorm(hs(c_bq, GQA_Q_HEADS), q_norm_b).reshape(
            B, L, GQA_KV_HEADS, GQA_GROUP, HEAD_DIM)
        c_b_att = _attend(cqb, ckb, cvb).reshape(B, L, GQA_WIDTH)
        out_c = _merge(c_a_att, c_b_att, c_az, c_bz, c_ga, c_gb, w_o_a, w_o_b, w_out)
        ctx = ctx + gate_c * out_c
    return x_new, ctx


def setup_inputs(seed: int = 0) -> dict:
    key = jax.random.key(seed)
    ks = jax.random.split(key, 16)
    f32 = jnp.float32
    nrm = lambda k, shape, s: jax.random.normal(k, shape, f32) * s
    return {
        "x": nrm(ks[0], (BATCH, SEQ, D_MODEL), 1.0),
        "c": nrm(ks[1], (BATCH, D_MODEL), 1.0),
        "ctx": nrm(ks[2], (BATCH, CTX_LEN, D_MODEL), 1.0),
        "c_ctx": nrm(ks[3], (D_MODEL,), 1.0),
        "w_ada": nrm(ks[4], (DEPTH, D_MODEL, 3 * D_MODEL), D_MODEL ** -0.5),
        "b_ada": nrm(ks[5], (DEPTH, 3 * D_MODEL), 0.02),
        "norm_g": 1.0 + nrm(ks[6], (DEPTH, D_MODEL), 0.05),
        "w_in": nrm(ks[7], (DEPTH, D_MODEL, IN_COLS), D_MODEL ** -0.5),
        "q_norm_a": 1.0 + nrm(ks[8], (DEPTH, HEAD_DIM), 0.05),
        "k_norm_a": 1.0 + nrm(ks[9], (DEPTH, HEAD_DIM), 0.05),
        "q_norm_b": 1.0 + nrm(ks[10], (DEPTH, HEAD_DIM), 0.05),
        "k_norm_b": 1.0 + nrm(ks[11], (DEPTH, HEAD_DIM), 0.05),
        "rpb": nrm(ks[12], (DEPTH, NA_HEADS, 2 * WIN_R - 1, 2 * WIN_C - 1), 0.1),
        "w_o_a": nrm(ks[13], (DEPTH, NA_WIDTH, D_MODEL), NA_WIDTH ** -0.5),
        "w_o_b": nrm(ks[14], (DEPTH, GQA_WIDTH, D_MODEL), GQA_WIDTH ** -0.5),
        "w_out": nrm(ks[15], (DEPTH, D_MODEL, D_MODEL), D_MODEL ** -0.5),
    }


def reference(x, c, ctx, c_ctx, w_ada, b_ada, norm_g, w_in, q_norm_a, k_norm_a,
              q_norm_b, k_norm_b, rpb, w_o_a, w_o_b, w_out):
    S = x.shape[1]
    t = jnp.arange(S, dtype=jnp.int32)
    pos_row = t // GRID_W
    pos_col = t % GRID_W
    for l in range(DEPTH):
        x, ctx = _layer(x, ctx, c, c_ctx, w_ada[l], b_ada[l], norm_g[l], w_in[l],
                        q_norm_a[l], k_norm_a[l], q_norm_b[l], k_norm_b[l], rpb[l],
                        w_o_a[l], w_o_b[l], w_out[l], pos_row, pos_col,
                        l < DEPTH - 1)
    return x
```

```cpp
#include <hip/hip_runtime.h>
#include <hip/hip_bf16.h>
#include <cstdio>
#include <cstdint>
#include <cmath>

#define LAS __attribute__((address_space(3)))
#define GAS __attribute__((address_space(1)))
typedef unsigned short bf16_t;
typedef short bf16x8 __attribute__((ext_vector_type(8)));
typedef short s16x4 __attribute__((ext_vector_type(4)));
typedef float f32x4 __attribute__((ext_vector_type(4)));
typedef float f32x16 __attribute__((ext_vector_type(16)));
typedef unsigned u32x4 __attribute__((ext_vector_type(4)));
typedef float f32x2_t __attribute__((ext_vector_type(2)));
typedef __bf16 bf16x2_t __attribute__((ext_vector_type(2)));

constexpr int DM = 1024, NB = 4, SEQ = 4096, CTXL = 256, HD = 64;
constexpr int ML = NB * SEQ;
constexpr int MC = NB * CTXL;
constexpr int MT = ML + MC;
constexpr int INC = 5376;
constexpr int KVR = CTXL + SEQ;
constexpr int QP = 512;
constexpr float EPS = 1e-6f;
constexpr float LOG2E = 1.4426950408889634f;
constexpr float C2 = 0.125f * LOG2E;

constexpr size_t MiB = 1u << 20;
constexpr size_t WS_CTL = 0, CTL_ZERO_BYTES = 1 * MiB;
constexpr size_t WS_MOD = 1 * MiB;
constexpr size_t WS_ROPE = 1 * MiB + 256 * 1024;
constexpr size_t WS_NW = 1 * MiB + 512 * 1024;
constexpr size_t WS_WIN = 2 * MiB;
constexpr size_t WS_WOA = 23 * MiB;
constexpr size_t WS_WOB = 25 * MiB;
constexpr size_t WS_WOUT = 27 * MiB;
constexpr size_t WS_CTXN = 31 * MiB;
constexpr size_t WS_HX = 36 * MiB;
constexpr size_t WS_KA = 70 * MiB;
constexpr size_t WS_VA = 87 * MiB;
constexpr size_t WS_KB = 104 * MiB;
constexpr size_t WS_VB = 109 * MiB;
constexpr size_t WS_QA = 114 * MiB;
constexpr size_t WS_QB = 131 * MiB;
constexpr size_t WS_SZA = 148 * MiB;
constexpr size_t WS_SZB = 165 * MiB;
constexpr size_t WS_SGA = 182 * MiB;
constexpr size_t WS_SGB = 216 * MiB;
constexpr size_t WS_END = 250 * MiB;
constexpr int CW_BAR = 4096;

constexpr int RING_BYTES = 131072;
constexpr int LDSCTL_OFF = RING_BYTES, MISC_OFF = LDSCTL_OFF + 320;
constexpr int LDS_BYTES = 147456;
constexpr int NWAVES = 8;

#define LDS_WAIT() asm volatile("s_waitcnt lgkmcnt(0)" ::: "memory")
#define VM_WAIT() asm volatile("s_waitcnt vmcnt(0)" ::: "memory")

__device__ __forceinline__ unsigned cvtpk(float lo, float hi) { f32x2_t v = {lo, hi}; bf16x2_t b = __builtin_convertvector(v, bf16x2_t); return __builtin_bit_cast(unsigned, b); }
__device__ __forceinline__ float bflo(unsigned u) { return __builtin_bit_cast(float, u << 16); }
__device__ __forceinline__ float bfhi(unsigned u) { return __builtin_bit_cast(float, u & 0xffff0000u); }
typedef GAS unsigned char* gptr;
__device__ __forceinline__ gptr launder(unsigned char* p) { asm volatile("" : "+s"(p)); return (gptr)p; }
__device__ __forceinline__ float fsigmoid(float v) { return __builtin_amdgcn_rcpf(1.0f + __builtin_amdgcn_exp2f(-v * LOG2E)); }

namespace pg8 {
constexpr int BM = 256, BK = 64, HALF = 128, HTB = HALF * BK * 2, NXCD = 8, WGM = 8;
__host__ __device__ __forceinline__ int lds_byte(int r, int c) { const int st = (r >> 4) * 2 + (c >> 5), rr = r & 15, cc = c & 31, ob = rr * 64 + cc * 2; return st * 1024 + (ob ^ (((ob >> 9) & 1) << 5)); }
__host__ __device__ __forceinline__ void stage_rc(int b, int& R, int& C) { const int st = b / 1024, sb = b % 1024, swz = sb ^ (((sb >> 9) & 1) << 5); R = (st >> 1) * 16 + swz / 64; C = (st & 1) * 32 + (swz % 64) / 2; }
__host__ __device__ __forceinline__ int perm32(int rho) { const int n = rho >> 4, i = rho & 15; return 8 * (i >> 2) + 4 * n + (i & 3); }

struct Unit { int pm, pn, sub; };

__device__ __forceinline__ void tile_of(int L, int nM, int nN, int& pm, int& pn) {
    const int nwg = nM * nN; int wgid = L;
    { const int q = nwg / NXCD, r = nwg % NXCD, xcd = wgid % NXCD, off = wgid / NXCD; wgid = (xcd < r ? xcd * (q + 1) : r * (q + 1) + (xcd - r) * q) + off; }
    const int nig = WGM * nN, gid = wgid / nig, fm = gid * WGM, gsz = (nM - fm) < WGM ? (nM - fm) : WGM;
    pm = fm + ((wgid % nig) % gsz); pn = (wgid % nig) / gsz;
}

template <class P, int K>
__device__ __forceinline__ void gemm_phase(LAS unsigned char* lds, const P& p) {
    int tid_ = threadIdx.x; asm volatile("" : "+v"(tid_));
    const int tid = tid_, wid = __builtin_amdgcn_readfirstlane(tid >> 6), lane = tid & 63, wr = wid >> 2, wc = wid & 3, fr = lane & 15, fq = lane >> 4;
    constexpr int nt = K / BK;
    unsigned voffA[2], voffB[2];
#pragma unroll
    for (int i = 0; i < 2; ++i) { int R, C; stage_rc(tid * 16 + i * 8192, R, C); const int Rb = P::brow(R);
        voffA[i] = (unsigned)(R * K + C) * 2u; voffB[i] = (unsigned)(Rb * K + C) * 2u; }
    constexpr size_t kstep = (size_t)(BK * 2);
    constexpr size_t hstepA = (size_t)HALF * K * 2;
    constexpr size_t hstepB = (size_t)P::BHALF_ROWS * K * 2;
    const unsigned ldsw = (unsigned)wid * 1024u;
    const int aoff = lds_byte(wr * 64 + fr, fq * 8), boff = lds_byte(wc * 32 + fr, fq * 8);
#define PG8_SA(b, h) (((b) * 2 + (h)) * HTB)
#define PG8_SB(b, h) ((4 + (b) * 2 + (h)) * HTB)
#define PG8_STAGE(bufoff, gbase, voff) do { _Pragma("unroll") for (int _i = 0; _i < 2; ++_i) \
        __builtin_amdgcn_global_load_lds((const unsigned*)((const char*)(gbase) + (voff)[_i]), (LAS unsigned*)(lds + (bufoff) + ldsw + _i * 8192), 16, 0, 0); } while (0)
#define PG8_LDA(dst, b, h) do { _Pragma("unroll") for (int m = 0; m < 4; ++m) _Pragma("unroll") for (int k = 0; k < 2; ++k) dst[m][k] = *(const LAS bf16x8*)(lds + PG8_SA(b, h) + aoff + m * 2048 + k * 1024); } while (0)
#define PG8_LDB(dst, b, h) do { _Pragma("unroll") for (int n = 0; n < 2; ++n) _Pragma("unroll") for (int k = 0; k < 2; ++k) dst[n][k] = *(const LAS bf16x8*)(lds + PG8_SB(b, h) + boff + n * 2048 + k * 1024); } while (0)
#define PG8_MMA(ai, bj, At, Bt) do { __builtin_amdgcn_s_setprio(1); _Pragma("unroll") for (int m = 0; m < 4; ++m) _Pragma("unroll") for (int n = 0; n < 2; ++n) _Pragma("unroll") for (int k = 0; k < 2; ++k) \
        acc[ai][bj][m][n] = __builtin_amdgcn_mfma_f32_16x16x32_bf16(Bt[n][k], At[m][k], acc[ai][bj][m][n], 0, 0, 0); __builtin_amdgcn_s_setprio(0); } while (0)
#define PG8_WAIT_V(n) asm volatile("s_waitcnt vmcnt(" #n ")" ::: "memory")
#define PG8_WAIT_L(n) asm volatile("s_waitcnt lgkmcnt(" #n ")" ::: "memory")
#define PG8_BAR __builtin_amdgcn_s_barrier()
#define PG8_SCHED __builtin_amdgcn_sched_barrier(0)
    Unit cur, nxt; int ui = 0;
    if (!p.next(0, cur)) return;
    f32x4 acc[2][2][4][2];
#pragma unroll
    for (int a = 0; a < 2; ++a)
#pragma unroll
        for (int b = 0; b < 2; ++b)
#pragma unroll
            for (int m = 0; m < 4; ++m)
#pragma unroll
                for (int n = 0; n < 2; ++n) acc[a][b][m][n] = (f32x4){0.f, 0.f, 0.f, 0.f};
    bf16x8 At[4][2], B0[2][2], B1[2][2];
    const char* cA = p.aptr(cur); const char* cB = p.bptr(cur);
    PG8_STAGE(PG8_SB(0, 0), cB, voffB); PG8_STAGE(PG8_SB(0, 1), cB + hstepB, voffB); PG8_STAGE(PG8_SA(0, 0), cA, voffA); PG8_STAGE(PG8_SA(0, 1), cA + hstepA, voffA);
    if (wr == 1) PG8_BAR;
    PG8_WAIT_V(2); PG8_BAR;
    PG8_STAGE(PG8_SB(1, 0), cB + kstep, voffB); PG8_STAGE(PG8_SA(1, 0), cA + kstep, voffA); PG8_STAGE(PG8_SB(1, 1), cB + hstepB + kstep, voffB);
    PG8_WAIT_V(6); PG8_BAR;
    for (;;) {
        const bool has_next = p.next(ui + 1, nxt);
        const char* nA = has_next ? p.aptr(nxt) : cA; const char* nB = has_next ? p.bptr(nxt) : cB;
        for (int t = 0; t < nt; t += 2) {
            const bool last = (t == nt - 2);
            const char* a1 = cA + (size_t)(t + 1) * kstep;
            const char* a2 = last ? nA : cA + (size_t)(t + 2) * kstep; const char* b2 = last ? nB : cB + (size_t)(t + 2) * kstep;
            const char* a3 = a2 + kstep; const char* b3 = b2 + kstep;
            PG8_LDB(B0, 0, 0); PG8_LDB(B1, 0, 1); PG8_SCHED; PG8_LDA(At, 0, 0); PG8_STAGE(PG8_SA(1, 1), a1 + hstepA, voffA);
            PG8_WAIT_V(8); PG8_WAIT_L(0); PG8_BAR; PG8_MMA(0, 0, At, B0); PG8_MMA(0, 1, At, B1); PG8_BAR; PG8_SCHED;
            PG8_LDA(At, 0, 1); PG8_STAGE(PG8_SB(0, 0), b2, voffB); PG8_STAGE(PG8_SB(0, 1), b2 + hstepB, voffB); PG8_STAGE(PG8_SA(0, 0), a2, voffA);
            PG8_WAIT_V(8); PG8_WAIT_L(0); PG8_BAR; PG8_MMA(1, 0, At, B0); PG8_MMA(1, 1, At, B1); PG8_BAR; PG8_SCHED;
            PG8_LDB(B0, 1, 0); PG8_LDB(B1, 1, 1); PG8_SCHED; PG8_LDA(At, 1, 0); PG8_STAGE(PG8_SA(0, 1), a2 + hstepA, voffA);
            PG8_WAIT_V(8); PG8_WAIT_L(0); PG8_BAR; PG8_MMA(0, 0, At, B0); PG8_MMA(0, 1, At, B1); PG8_BAR; PG8_SCHED;
            PG8_LDA(At, 1, 1); PG8_STAGE(PG8_SB(1, 0), b3, voffB); PG8_STAGE(PG8_SB(1, 1), b3 + hstepB, voffB); PG8_STAGE(PG8_SA(1, 0), a3, voffA);
            PG8_WAIT_V(8); PG8_WAIT_L(0); PG8_BAR; PG8_MMA(1, 0, At, B0); PG8_MMA(1, 1, At, B1); PG8_BAR; PG8_SCHED;
        }
        if (wr == 0) PG8_BAR;
        p.epi(acc, cur, wr, wc, fr, fq);
        if (!has_next) break;
        if (!p.keep(cur)) {
#pragma unroll
            for (int a = 0; a < 2; ++a)
#pragma unroll
                for (int b = 0; b < 2; ++b)
#pragma unroll
                    for (int m = 0; m < 4; ++m)
#pragma unroll
                        for (int n = 0; n < 2; ++n) acc[a][b][m][n] = (f32x4){0.f, 0.f, 0.f, 0.f};
        }
        cur = nxt; cA = nA; cB = nB; ++ui;
        if (wr == 1) PG8_BAR;
    }
    PG8_WAIT_V(0);
    PG8_BAR;
#undef PG8_SA
#undef PG8_SB
#undef PG8_STAGE
#undef PG8_LDA
#undef PG8_LDB
#undef PG8_MMA
#undef PG8_WAIT_V
#undef PG8_WAIT_L
#undef PG8_BAR
#undef PG8_SCHED
}
}

struct InProj {
    static constexpr int BHALF_ROWS = 16;
    __host__ __device__ static int brow(int R) { return 64 * (R >> 5) + 8 * (((R >> 2) & 1) + 4 * ((R >> 3) & 1)) + 4 * ((R >> 4) & 1) + (R & 3); }
    unsigned char* ws; int layer;
    int nM, nmain, nextra, G, c;
    __device__ __forceinline__ bool next(int i, pg8::Unit& u) const {
        const int L = i * G + c; if (L >= nmain + nextra) return false;
        if (L < nmain) pg8::tile_of(L, nM, 21, u.pm, u.pn); else { const int r = L - nmain; u.pm = 64 + r / 5; u.pn = r % 5; }
        u.sub = 0; return true;
    }
    __device__ __forceinline__ const char* aptr(const pg8::Unit& u) const { return (const char*)(ws + WS_HX) + (size_t)u.pm * 256 * DM * 2; }
    __device__ __forceinline__ const char* bptr(const pg8::Unit& u) const { return (const char*)(ws + WS_WIN) + ((size_t)layer * INC + (size_t)u.pn * 256) * DM * 2; }
    __device__ __forceinline__ bool keep(const pg8::Unit&) const { return false; }
    __device__ __forceinline__ void epi(f32x4 (&acc)[2][2][4][2], const pg8::Unit& u, int wr, int wc, int fr, int fq) const {
        const int pn = u.pn, pm = u.pm;
        gptr wl = launder(ws);
        GAS bf16_t* KA = (GAS bf16_t*)(wl + WS_KA); GAS bf16_t* VA = (GAS bf16_t*)(wl + WS_VA); GAS bf16_t* KB = (GAS bf16_t*)(wl + WS_KB); GAS bf16_t* VB = (GAS bf16_t*)(wl + WS_VB);
        GAS bf16_t* QA = (GAS bf16_t*)(wl + WS_QA); GAS bf16_t* QB = (GAS bf16_t*)(wl + WS_QB); GAS bf16_t* SZA = (GAS bf16_t*)(wl + WS_SZA); GAS bf16_t* SZB = (GAS bf16_t*)(wl + WS_SZB);
        GAS bf16_t* SGA = (GAS bf16_t*)(wl + WS_SGA); GAS bf16_t* SGB = (GAS bf16_t*)(wl + WS_SGB);
        const GAS float* nwt = (const GAS float*)(wl + WS_NW) + layer * 256; const GAS float* qna = nwt; const GAS float* kna = nwt + 64; const GAS float* qnb = nwt + 128; const GAS float* knb = nwt + 192;
        const GAS float* rope = (const GAS float*)(wl + WS_ROPE);
        const bool ctxrow = pm >= 64;
        const int kv0 = ctxrow ? (pm - 64) * KVR : ((pm >> 4) * KVR + CTXL + (pm & 15) * 256);
        const int c0 = (fq & 1) + 4 * (fq >> 1);
        const int hcol = 64 * wc;
        int type; GAS bf16_t* dst; int pitch, rowbase; const GAS float* nw = nullptr; bool rope_on = false; float osc = 1.f;
        if (pn < 2)       { type = 1; dst = KA + pn * 256 + hcol; pitch = 512; rowbase = kv0; nw = kna; }
        else if (pn < 4)  { type = 0; dst = VA + (pn - 2) * 256 + hcol; pitch = 512; rowbase = kv0; }
        else if (pn == 4) { if (wc < 2) { type = 1; dst = KB + hcol; pitch = 128; rowbase = kv0; nw = knb; rope_on = !ctxrow; }
                            else        { type = 0; dst = VB + (hcol - 128); pitch = 128; rowbase = kv0; } }
        else if (pn < 7)  { type = 1; dst = QA + (pn - 5) * 256 + hcol; pitch = QP; rowbase = pm * 256; nw = qna; osc = C2; }
        else if (pn < 9)  { type = 1; dst = QB + (pn - 7) * 256 + hcol; pitch = QP; rowbase = pm * 256; nw = qnb; rope_on = !ctxrow; osc = C2; }
        else if (pn < 11) { type = 2; dst = SZA + (pn - 9) * 256 + hcol; pitch = QP; rowbase = pm * 256; }
        else if (pn < 13) { type = 2; dst = SZB + (pn - 11) * 256 + hcol; pitch = QP; rowbase = pm * 256; }
        else if (pn < 17) { type = 3; dst = SGA + (pn - 13) * 256 + hcol; pitch = DM; rowbase = pm * 256; }
        else              { type = 3; dst = SGB + (pn - 17) * 256 + hcol; pitch = DM; rowbase = pm * 256; }
        float w[2][8];
        if (type == 1) {
#pragma unroll
            for (int bj = 0; bj < 2; ++bj) { const f32x4 a = *(const GAS f32x4*)(nw + 8 * (c0 + 2 * bj)), b = *(const GAS f32x4*)(nw + 8 * (c0 + 2 * bj) + 4);
                w[bj][0] = a[0] * osc; w[bj][1] = a[1] * osc; w[bj][2] = a[2] * osc; w[bj][3] = a[3] * osc; w[bj][4] = b[0] * osc; w[bj][5] = b[1] * osc; w[bj][6] = b[2] * osc; w[bj][7] = b[3] * osc; }
        }
#pragma unroll
        for (int ai = 0; ai < 2; ++ai)
#pragma unroll
            for (int m = 0; m < 4; ++m) {
                const int rr = 128 * ai + 64 * wr + 16 * m + fr;
                float v[2][8];
#pragma unroll
                for (int bj = 0; bj < 2; ++bj)
#pragma unroll
                    for (int n = 0; n < 2; ++n)
#pragma unroll
                        for (int e = 0; e < 4; ++e) v[bj][4 * n + e] = acc[ai][bj][m][n][e];
                if (type == 1) {
                    float ss = 0.f;
#pragma unroll
                    for (int bj = 0; bj < 2; ++bj)
#pragma unroll
                        for (int i = 0; i < 8; ++i) ss += v[bj][i] * v[bj][i];
                    ss += __shfl_xor(ss, 16); ss += __shfl_xor(ss, 32);
                    const float rinv = __builtin_amdgcn_rsqf(ss * (1.0f / 64.0f) + EPS);
#pragma unroll
                    for (int bj = 0; bj < 2; ++bj)
#pragma unroll
                        for (int i = 0; i < 8; ++i) v[bj][i] = v[bj][i] * rinv * w[bj][i];
                    if (rope_on) {
                        const int t = (pm & 15) * 256 + rr;
                        const int pos = (fq >> 1) ? (t & 63) : (t >> 6);
                        const GAS float* tb = rope + (size_t)(pos * 16 + 8 * (fq & 1)) * 2;
#pragma unroll
                        for (int q4 = 0; q4 < 4; ++q4) { const f32x4 cs = *(const GAS f32x4*)(tb + 4 * q4);
                            { const int i = 2 * q4; const float x1 = v[0][i], x2 = v[1][i]; v[0][i] = x1 * cs[0] - x2 * cs[1]; v[1][i] = x2 * cs[0] + x1 * cs[1]; }
                            { const int i = 2 * q4 + 1; const float x1 = v[0][i], x2 = v[1][i]; v[0][i] = x1 * cs[2] - x2 * cs[3]; v[1][i] = x2 * cs[2] + x1 * cs[3]; } }
                    }
                } else if (type == 2) {
#pragma unroll
                    for (int bj = 0; bj < 2; ++bj)
#pragma unroll
                        for (int i = 0; i < 8; ++i) v[bj][i] = v[bj][i] * fsigmoid(v[bj][i]);
                } else if (type == 3) {
#pragma unroll
                    for (int bj = 0; bj < 2; ++bj)
#pragma unroll
                        for (int i = 0; i < 8; ++i) v[bj][i] = fsigmoid(v[bj][i]);
                }
                GAS bf16_t* rowp = dst + (size_t)(rowbase + rr) * pitch;
#pragma unroll
                for (int bj = 0; bj < 2; ++bj) { u32x4 o; o.x = cvtpk(v[bj][0], v[bj][1]); o.y = cvtpk(v[bj][2], v[bj][3]); o.z = cvtpk(v[bj][4], v[bj][5]); o.w = cvtpk(v[bj][6], v[bj][7]);
                    *(GAS u32x4*)(rowp + 8 * (c0 + 2 * bj)) = o; }
            }
    }
};

struct MergeProj {
    static constexpr int BHALF_ROWS = 128;
    __host__ __device__ static int brow(int R) { return (R & ~31) + pg8::perm32(R & 31); }
    unsigned char* ws; int layer;
    int nM, G, c;
    __device__ __forceinline__ bool next(int i, pg8::Unit& u) const {
        const int L = (i >> 1) * G + c; if (L >= nM * 4) return false;
        pg8::tile_of(L, nM, 4, u.pm, u.pn); u.sub = i & 1; return true;
    }
    __device__ __forceinline__ const char* aptr(const pg8::Unit& u) const { return (const char*)(ws + (u.sub ? WS_QB : WS_QA)) + (size_t)u.pm * 256 * 512 * 2; }
    __device__ __forceinline__ const char* bptr(const pg8::Unit& u) const { return (const char*)(ws + (u.sub ? WS_WOB : WS_WOA)) + ((size_t)layer * DM + (size_t)u.pn * 256) * 512 * 2; }
    __device__ __forceinline__ bool keep(const pg8::Unit& u) const { return u.sub == 0; }
    __device__ __forceinline__ void epi(f32x4 (&acc)[2][2][4][2], const pg8::Unit& u, int wr, int wc, int fr, int fq) const {
        const int row0 = u.pm * 256 + wr * 64 + fr, col0 = u.pn * 256 + wc * 32 + 8 * fq;
        gptr wl = launder(ws);
        const GAS bf16_t* SGA = (const GAS bf16_t*)(wl + WS_SGA); const GAS bf16_t* SGB = (const GAS bf16_t*)(wl + WS_SGB); GAS bf16_t* MG = (GAS bf16_t*)(wl + WS_HX);
#pragma unroll
        for (int ai = 0; ai < 2; ++ai)
#pragma unroll
            for (int m = 0; m < 4; ++m) {
                const size_t off = (size_t)(row0 + ai * 128 + m * 16) * DM + col0;
#pragma unroll
                for (int bj = 0; bj < 2; ++bj) {
                    const u32x4 sb = *(const GAS u32x4*)(SGB + off + bj * 128);
                    float b[8] = {bflo(sb.x), bfhi(sb.x), bflo(sb.y), bfhi(sb.y), bflo(sb.z), bfhi(sb.z), bflo(sb.w), bfhi(sb.w)};
#pragma unroll
                    for (int i = 0; i < 8; ++i) b[i] = fmaxf(b[i], 1e-30f);
                    if (u.sub == 0) {
                        const u32x4 sa = *(const GAS u32x4*)(SGA + off + bj * 128);
                        const float a[8] = {bflo(sa.x), bfhi(sa.x), bflo(sa.y), bfhi(sa.y), bflo(sa.z), bfhi(sa.z), bflo(sa.w), bfhi(sa.w)};
#pragma unroll
                        for (int n = 0; n < 2; ++n)
#pragma unroll
                            for (int e = 0; e < 4; ++e) acc[ai][bj][m][n][e] *= a[4 * n + e] * __builtin_amdgcn_rcpf(b[4 * n + e]);
                    } else {
                        float o[8];
#pragma unroll
                        for (int n = 0; n < 2; ++n)
#pragma unroll
                            for (int e = 0; e < 4; ++e) o[4 * n + e] = acc[ai][bj][m][n][e] * b[4 * n + e];
                        u32x4 w; w.x = cvtpk(o[0], o[1]); w.y = cvtpk(o[2], o[3]); w.z = cvtpk(o[4], o[5]); w.w = cvtpk(o[6], o[7]);
                        *(GAS u32x4*)(MG + off + bj * 128) = w;
                    }
                }
            }
    }
};

struct OutProj {
    static constexpr int BHALF_ROWS = 128;
    __host__ __device__ static int brow(int R) { return R; }
    unsigned char* ws; int layer; const GAS float* xin; GAS float* xout; const GAS float* cin;
    int nM, G, c;
    __device__ __forceinline__ bool next(int i, pg8::Unit& u) const {
        const int L = i * G + c; if (L >= nM * 4) return false;
        pg8::tile_of(L, nM, 4, u.pm, u.pn); u.sub = 0; return true;
    }
    __device__ __forceinline__ const char* aptr(const pg8::Unit& u) const { return (const char*)(ws + WS_HX) + (size_t)u.pm * 256 * DM * 2; }
    __device__ __forceinline__ const char* bptr(const pg8::Unit& u) const { return (const char*)(ws + WS_WOUT) + ((size_t)layer * DM + (size_t)u.pn * 256) * DM * 2; }
    __device__ __forceinline__ bool keep(const pg8::Unit&) const { return false; }
    __device__ __forceinline__ void epi(f32x4 (&acc)[2][2][4][2], const pg8::Unit& u, int wr, int wc, int fr, int fq) const {
        const bool ctxrow = u.pm >= 64;
        gptr wl = launder(ws);
        GAS float* cout = (GAS float*)(wl + WS_CTXN); const GAS float* mod = (const GAS float*)(wl + WS_MOD) + (size_t)layer * 5 * 3072;
        const GAS float* src = ctxrow ? cin + (size_t)(u.pm - 64) * 256 * DM : xin + (size_t)u.pm * 256 * DM;
        GAS float* dstp = ctxrow ? cout + (size_t)(u.pm - 64) * 256 * DM : xout + (size_t)u.pm * 256 * DM;
        const GAS float* gate = mod + (ctxrow ? 4 : (u.pm >> 4)) * 3072 + 2048;
        const int col0 = u.pn * 256 + wc * 32 + 4 * fq;
        f32x4 gv[2][2];
#pragma unroll
        for (int bj = 0; bj < 2; ++bj)
#pragma unroll
            for (int n = 0; n < 2; ++n) gv[bj][n] = *(const GAS f32x4*)(gate + col0 + bj * 128 + n * 16);
#pragma unroll
        for (int ai = 0; ai < 2; ++ai)
#pragma unroll
            for (int m = 0; m < 4; ++m) {
                const size_t off = (size_t)(ai * 128 + wr * 64 + m * 16 + fr) * DM + col0;
#pragma unroll
                for (int bj = 0; bj < 2; ++bj)
#pragma unroll
                    for (int n = 0; n < 2; ++n) { const f32x4 xs = *(const GAS f32x4*)(src + off + bj * 128 + n * 16);
                        *(GAS f32x4*)(dstp + off + bj * 128 + n * 16) = xs + gv[bj][n] * acc[ai][bj][m][n]; }
                if (m & 1) asm volatile("" ::: "memory");
            }
    }
};

namespace attn_body {
constexpr int NW = 8, QBLK = 32, KVBLK = 64;
__device__ __forceinline__ int crow(int r, int hi) { return (r & 3) + 8 * (r >> 2) + 4 * hi; }
#define SBAR() __builtin_amdgcn_sched_barrier(0)
constexpr int NSLOT = 3, SLOTB = 8192;
constexpr int LDS_K = 0, LDS_V = NSLOT * SLOTB, LDS_WS = 2 * NSLOT * SLOTB, LDS_OST = LDS_WS + NW * 64 * 4, LDS_TAB = LDS_OST + NW * 4096, LDS_BYTES_A = LDS_TAB + 4096;
constexpr int TABM = 64, ZOFF = 640;
__device__ __forceinline__ void glds16(const GAS void* gsrc, unsigned lds_dst) { unsigned keep;
    asm volatile("s_mov_b32 %0, m0\n\ts_mov_b32 m0, %2\n\ts_nop 0\n\tglobal_load_lds_dwordx4 %1, off\n\ts_mov_b32 m0, %0" : "=&s"(keep) : "v"(gsrc), "s"(lds_dst) : "memory"); }
__device__ __forceinline__ float max3f(float a, float b, float c) { float r; asm("v_max3_f32 %0, %1, %2, %3" : "=v"(r) : "v"(a), "v"(b), "v"(c)); return r; }
__device__ __forceinline__ float max2f(float a, float b) { float r; asm("v_max_f32_e32 %0, %1, %2" : "=v"(r) : "v"(a), "v"(b)); return r; }
__device__ __forceinline__ float fadd_s(float a, float b) { float r; asm("v_add_f32_e32 %0, %1, %2" : "=v"(r) : "v"(a), "v"(b)); return r; }
__device__ __forceinline__ float fsub_s(float a, float b) { float r; asm("v_sub_f32_e32 %0, %1, %2" : "=v"(r) : "v"(a), "v"(b)); return r; }
#define WAIT_BAR(N) asm volatile("s_waitcnt vmcnt(" #N ") lgkmcnt(0)\n\ts_barrier" ::: "memory")

__device__ __forceinline__ void qkt(f32x16& p0, f32x16& p1, const char* Kslot, const bf16x8* qr, const f32x16& negm, int r32, int hi) {
    const char* kb = Kslot + hi * 1024 + r32 * 16;
#pragma unroll
    for (int d0 = 0; d0 < 4; ++d0) {
        const bf16x8 b0 = *reinterpret_cast<const bf16x8*>(kb + d0 * 2048);
        const bf16x8 b1 = *reinterpret_cast<const bf16x8*>(kb + d0 * 2048 + 512);
        if (d0 == 0) { p0 = __builtin_amdgcn_mfma_f32_32x32x16_bf16(b0, qr[0], negm, 0, 0, 0); p1 = __builtin_amdgcn_mfma_f32_32x32x16_bf16(b1, qr[0], negm, 0, 0, 0); }
        else { p0 = __builtin_amdgcn_mfma_f32_32x32x16_bf16(b0, qr[d0], p0, 0, 0, 0); p1 = __builtin_amdgcn_mfma_f32_32x32x16_bf16(b1, qr[d0], p1, 0, 0, 0); } }
}
typedef LAS const char* lds_cptr;
typedef short v4i16_t __attribute__((ext_vector_type(4)));
__device__ __forceinline__ void kload8(bf16x8* kf, lds_cptr kp) {
    kf[0] = *(const LAS bf16x8*)(kp);        kf[1] = *(const LAS bf16x8*)(kp + 512);
    kf[2] = *(const LAS bf16x8*)(kp + 2048); kf[3] = *(const LAS bf16x8*)(kp + 2560);
    kf[4] = *(const LAS bf16x8*)(kp + 4096); kf[5] = *(const LAS bf16x8*)(kp + 4608);
    kf[6] = *(const LAS bf16x8*)(kp + 6144); kf[7] = *(const LAS bf16x8*)(kp + 6656);
}
__device__ __forceinline__ void kload2(bf16x8* kf, lds_cptr kp, int j) { kf[2 * j] = *(const LAS bf16x8*)(kp + j * 2048); kf[2 * j + 1] = *(const LAS bf16x8*)(kp + j * 2048 + 512); }
__device__ __forceinline__ s16x4 vtr(lds_cptr p) { return __builtin_bit_cast(s16x4, __builtin_amdgcn_ds_read_tr16_b64_v4i16((LAS v4i16_t*)p)); }
__device__ __forceinline__ float rowmax(const f32x16& p0, const f32x16& p1) {
    float a = max3f(p0[0], p0[1], p1[0]), b = max3f(p0[2], p0[3], p1[1]); a = max3f(a, p1[2], p1[3]);
#pragma unroll
    for (int r = 4; r < 16; r += 4) { a = max3f(a, p0[r], p0[r + 1]); b = max3f(b, p0[r + 2], p0[r + 3]); a = max3f(a, p1[r], p1[r + 1]); b = max3f(b, p1[r + 2], p1[r + 3]); }
    const float m = max2f(a, b);
    auto rr = __builtin_amdgcn_permlane32_swap(__float_as_uint(m), __float_as_uint(m), false, false);
    return max2f(__uint_as_float(rr[0]), __uint_as_float(rr[1]));
}
__device__ __forceinline__ void pv(f32x16* o, int vb, bf16x8 pa0, bf16x8 pa1, bf16x8 pa2, bf16x8 pa3) {
#pragma unroll
    for (int d0 = 0; d0 < 2; ++d0) { s16x4 lo[4], hi[4];
#pragma unroll
        for (int ks = 0; ks < 4; ++ks) {
            asm volatile("ds_read_b64_tr_b16 %0,%1 offset:%c2" : "=&v"(lo[ks]) : "v"(vb), "i"(d0 * 4096 + ks * 1024) : "memory");
            asm volatile("ds_read_b64_tr_b16 %0,%1 offset:%c2" : "=&v"(hi[ks]) : "v"(vb), "i"(d0 * 4096 + ks * 1024 + 512) : "memory"); }
        asm volatile("s_waitcnt lgkmcnt(0)" ::: "memory"); SBAR();
#define PK(k) (bf16x8){lo[k][0], lo[k][1], lo[k][2], lo[k][3], hi[k][0], hi[k][1], hi[k][2], hi[k][3]}
        o[d0] = __builtin_amdgcn_mfma_f32_32x32x16_bf16(pa0, PK(0), o[d0], 0, 0, 0);
        o[d0] = __builtin_amdgcn_mfma_f32_32x32x16_bf16(pa1, PK(1), o[d0], 0, 0, 0);
        o[d0] = __builtin_amdgcn_mfma_f32_32x32x16_bf16(pa2, PK(2), o[d0], 0, 0, 0);
        o[d0] = __builtin_amdgcn_mfma_f32_32x32x16_bf16(pa3, PK(3), o[d0], 0, 0, 0);
#undef PK
    }
}

template <int MODE, int KP, int THRL>
__device__ __forceinline__ void attn_unit(const GAS bf16_t* Qw0, const GAS bf16_t* Kh, const GAS bf16_t* Vh, const int NT, const int lo,
                                          GAS bf16_t* Ow0, const GAS bf16_t* Zw0, const int qr0, const GAS float* rpbh, char* shm) {
    int tid_ = threadIdx.x; asm volatile("" : "+v"(tid_));
    const int tid = tid_, lane = tid & 63, r32 = lane & 31, hi = lane >> 5; const int wid = __builtin_amdgcn_readfirstlane(tid >> 6);
    const GAS bf16_t* Qw = Qw0 + (long)(wid * QBLK) * QP;
    const unsigned lds0 = (unsigned)(uintptr_t)shm;
    float* wsf = (float*)(shm + LDS_WS) + wid * 64;
    const GAS bf16_t* ksrc = Kh + (long)lane * KP + wid * 8;
    const GAS bf16_t* vsrc = Vh + (long)(16 * (wid & 3) + (lane >> 2)) * KP + (wid >> 2) * 32 + (lane & 3) * 8;
    const unsigned kdst = lds0 + LDS_K + wid * 1024, vdst = lds0 + LDS_V + wid * 1024;
#define TMAP(t) ((MODE == 1 && (t) >= 4) ? (t) + lo : (t))
#define DMA_K(t, slot) glds16(ksrc + (long)TMAP(t) * KVBLK * KP, (unsigned)__builtin_amdgcn_readfirstlane(kdst + (slot)))
#define DMA_V(t, slot) glds16(vsrc + (long)TMAP(t) * KVBLK * KP, (unsigned)__builtin_amdgcn_readfirstlane(vdst + (slot)))
    const int vb0 = (int)(lds0 + LDS_V) + ((lane >> 4) & 1) * 32 + (lane & 3) * 8 + (4 * hi + ((lane & 15) >> 2)) * 64;
    const char* Kbase = shm + LDS_K; bf16x8 kf[8];
    const lds_cptr shm3 = (lds_cptr)shm; const lds_cptr kp0 = shm3 + LDS_K + hi * 1024 + r32 * 16; const lds_cptr vp0 = shm3 + LDS_V + ((lane >> 4) & 1) * 32 + (lane & 3) * 8 + (4 * hi + ((lane & 15) >> 2)) * 64;
    DMA_K(0, 0); DMA_V(0, 0); DMA_K(1, SLOTB);
    bf16x8 qr[4];
#pragma unroll
    for (int d0 = 0; d0 < 4; ++d0) qr[d0] = *(const GAS bf16x8*)(Qw + (long)r32 * QP + d0 * 16 + hi * 8);
    int na_qr = 0, na_rs = 0, na_vb = 0; const LAS float* na_tb = nullptr; const LAS float* na_zb = nullptr;
    if (MODE == 1) {
        LAS float* tab = (LAS float*)(shm3 + LDS_TAB);
        for (int i = tid; i < 15 * 32; i += NW * 64) { const int dr = i >> 5, dc = i & 31; tab[TABM + i] = (dc < 31) ? rpbh[dr * 31 + dc] * LOG2E : 0.f; }
        for (int i = tid; i < 256; i += NW * 64) tab[ZOFF + i] = 0.f;
        na_qr = qr0 + (wid >> 1);
        na_rs = na_qr - 4; na_rs = na_rs < 0 ? 0 : (na_rs > 56 ? 56 : na_rs);
        const int qc = 32 * (wid & 1) + r32; int cs = qc - 8; cs = cs < 0 ? 0 : (cs > 48 ? 48 : cs);
        na_vb = 4 * hi - cs;
        na_tb = (const LAS float*)(shm3 + LDS_TAB) + TABM + (4 * hi - qc + 15);
        na_zb = (const LAS float*)(shm3 + LDS_TAB) + ZOFF + 64 + (4 * hi - qc + 15);
    }
    float mhat = 0.f, l_reg = 0.f; f32x16 o[2]; o[0] = f32x16{}; o[1] = f32x16{}; f32x16 negm = f32x16{}; if (MODE == 0) asm volatile("" : "+v"(negm));
#define CMASK(P0, P1, t) do { if (MODE == 1) { const float NEG_ = -INFINITY; \
        const int kr_ = lo + (t) - 4; const bool isw_ = (t) >= 4; const bool rok_ = isw_ && ((unsigned)(kr_ - na_rs) < 8u); \
        const LAS float* tb_ = rok_ ? na_tb + (kr_ - na_qr + 7) * 32 : na_zb; \
        int vb_ = isw_ ? na_vb : 4 * hi; const unsigned lim_ = isw_ ? (rok_ ? 16u : 0u) : 64u; asm volatile("" : "+v"(vb_)); \
        _Pragma("unroll") for (int g_ = 0; g_ < 4; ++g_) { \
          _Pragma("unroll") for (int r = 4 * g_; r < 4 * g_ + 4; ++r) { const int kc_ = (r & 3) + 8 * (r >> 2); const float b0_ = tb_[kc_] - mhat, b1_ = tb_[kc_ + 32] - mhat; \
            P0[r] = ((unsigned)(kc_ + vb_) < lim_) ? P0[r] + b0_ : NEG_; P1[r] = ((unsigned)(kc_ + 32 + vb_) < lim_) ? P1[r] + b1_ : NEG_; } \
          asm volatile("" : "+v"(P0), "+v"(P1)); SBAR(); } } } while (0)
    bool resc = false;
#define START(P0, P1) do { const float rm = rowmax(P0, P1); resc = false; \
    { const float dl = rm; mhat = fadd_s(mhat, dl); \
      _Pragma("unroll") for (int r = 0; r < 16; ++r) { P0[r] = fsub_s(P0[r], dl); P1[r] = fsub_s(P1[r], dl); } \
      if (MODE == 0) { _Pragma("unroll") for (int r = 0; r < 16; ++r) negm[r] = -mhat; asm volatile("" : "+v"(negm)); } } \
    _Pragma("unroll") for (int r = 0; r < 16; ++r) P0[r] = __builtin_amdgcn_exp2f(P0[r]); } while (0)
#define RESC() do { if (resc) { asm volatile("s_waitcnt lgkmcnt(0)" ::: "memory"); \
      _Pragma("unroll") for (int d_ = 0; d_ < 2; ++d_) _Pragma("unroll") for (int r = 0; r < 16; ++r) o[d_][r] *= wsf[crow(r, hi)]; } } while (0)
    f32x16 pA0, pA1, pB0, pB1;
    int sl_prev = 0, sl_cur = 0, sl_next = SLOTB;
#define ROT() do { sl_prev = sl_cur; sl_cur = sl_next; sl_next = (sl_next == (NSLOT - 1) * SLOTB) ? 0 : sl_next + SLOTB; } while (0)
    DMA_K(2, 2 * SLOTB);
    WAIT_BAR(3);
    qkt(pA0, pA1, Kbase, qr, negm, r32, hi); asm volatile("s_nop 15\n\ts_nop 7" : "+v"(pA0), "+v"(pA1));
    START(pA0, pA1);
    _Pragma("unroll") for (int r = 0; r < 16; ++r) pA1[r] = __builtin_amdgcn_exp2f(pA1[r]);
    WAIT_BAR(0);
    DMA_K(3, 0); DMA_V(1, SLOTB);
    ROT();
    kload8(kf, kp0 + sl_cur);
    WAIT_BAR(2);
    s16x4 vlo[8], vhi[8]; u32x4 pw0, pw1, pw2, pw3;
#define PKW(P, B) cvtpk(P[B], P[B + 1])
#define PAF(k) __builtin_bit_cast(bf16x8, pw##k)
#define VFR(i) (bf16x8){vlo[i][0], vlo[i][1], vlo[i][2], vlo[i][3], vhi[i][0], vhi[i][1], vhi[i][2], vhi[i][3]}
#define PIN(x) asm volatile("" : "+v"(x))
#define MX3(a, b, c) __builtin_fmaxf(__builtin_fmaxf((a), (b)), (c))
#define GAPA(MF, A0, A1, A2, A3, W0, W1, PW) do { MF; sacc += A0; sacc += A1; sacc += A2; sacc += A3; PIN(sacc); W0; W1; PIN(PW); SBAR(); } while (0)
#define EX(v) __builtin_amdgcn_exp2f(v)
#define GAPB(MF, X, B) do { MF; X[B] = EX(X[B]); X[B + 1] = EX(X[B + 1]); X[B + 2] = EX(X[B + 2]); X[B + 3] = EX(X[B + 3]); PIN(X); SBAR(); } while (0)
#define VRD(i) do { vlo[i] = vtr(vp_ + (((i) >> 2) * 4096 + ((i) & 3) * 1024)); vhi[i] = vtr(vp_ + (((i) >> 2) * 4096 + ((i) & 3) * 1024 + 512)); } while (0)
#define KRD(G, j) do { if (G) { kload2(kf, kp0 + sl_next, j); SBAR(); } } while (0)
#define STEP(C0, C1, P0, P1, t, GK, GV, GL) do { SBAR(); \
    const lds_cptr vp_ = vp0 + sl_prev; \
    VRD(0); SBAR(); float sacc = (P0[0] + P0[1]); \
    GAPA(C0 = __builtin_amdgcn_mfma_f32_32x32x16_bf16(kf[0], qr[0], negm, 0, 0, 0), P0[2], P0[3], P0[4], P0[5],     pw0[0] = PKW(P0, 0), pw0[1] = PKW(P0, 2), pw0); \
    VRD(4); SBAR(); GAPA(C1 = __builtin_amdgcn_mfma_f32_32x32x16_bf16(kf[1], qr[0], negm, 0, 0, 0), P0[6], P0[7], P0[8], P0[9],     pw0[2] = PKW(P0, 4), pw0[3] = PKW(P0, 6), pw0); \
    VRD(1); SBAR(); GAPA(C0 = __builtin_amdgcn_mfma_f32_32x32x16_bf16(kf[2], qr[1], C0, 0, 0, 0),   P0[10], P0[11], P0[12], P0[13], pw1[0] = PKW(P0, 8), pw1[1] = PKW(P0, 10), pw1); \
    VRD(5); SBAR(); GAPA(C1 = __builtin_amdgcn_mfma_f32_32x32x16_bf16(kf[3], qr[1], C1, 0, 0, 0),   P0[14], P0[15], P1[0], P1[1],   pw1[2] = PKW(P0, 12), pw1[3] = PKW(P0, 14), pw1); \
    VRD(2); SBAR(); GAPA(C0 = __builtin_amdgcn_mfma_f32_32x32x16_bf16(kf[4], qr[2], C0, 0, 0, 0),   P1[2], P1[3], P1[4], P1[5],     pw2[0] = PKW(P1, 0), pw2[1] = PKW(P1, 2), pw2); \
    VRD(6); SBAR(); GAPA(C1 = __builtin_amdgcn_mfma_f32_32x32x16_bf16(kf[5], qr[2], C1, 0, 0, 0),   P1[6], P1[7], P1[8], P1[9],     pw2[2] = PKW(P1, 4), pw2[3] = PKW(P1, 6), pw2); \
    VRD(3); SBAR(); GAPA(C0 = __builtin_amdgcn_mfma_f32_32x32x16_bf16(kf[6], qr[3], C0, 0, 0, 0),   P1[10], P1[11], P1[12], P1[13], pw3[0] = PKW(P1, 8), pw3[1] = PKW(P1, 10), pw3); \
    VRD(7); SBAR(); GAPA(C1 = __builtin_amdgcn_mfma_f32_32x32x16_bf16(kf[7], qr[3], C1, 0, 0, 0),   P1[14], P1[15], 0.f, 0.f,       pw3[2] = PKW(P1, 12), pw3[3] = PKW(P1, 14), pw3); \
    l_reg += sacc; \
    if (GK) { DMA_K((t) + 3, sl_cur); } if (GV) { DMA_V((t) + 1, sl_next); } \
    CMASK(C0, C1, t); \
    { float a = MX3(C0[0], C0[1], C1[0]), b = MX3(C0[2], C0[3], C1[1]); a = MX3(a, C1[2], C1[3]); \
      _Pragma("unroll") for (int r = 4; r < 16; r += 4) { a = MX3(a, C0[r], C0[r + 1]); b = MX3(b, C0[r + 2], C0[r + 3]); a = MX3(a, C1[r], C1[r + 1]); b = MX3(b, C1[r + 2], C1[r + 3]); } \
      float rm = __builtin_fmaxf(a, b); { auto rr = __builtin_amdgcn_permlane32_swap(__float_as_uint(rm), __float_as_uint(rm), false, false); rm = __builtin_fmaxf(__uint_as_float(rr[0]), __uint_as_float(rr[1])); } \
      resc = false; \
      if (__builtin_expect(__any(rm > (float)THRL), 0)) { const float dl = __builtin_fmaxf(rm, 0.f); mhat += dl; \
        _Pragma("unroll") for (int r = 0; r < 16; ++r) { C0[r] -= dl; C1[r] -= dl; } \
        if (MODE == 0) { _Pragma("unroll") for (int r = 0; r < 16; ++r) negm[r] = -mhat; asm volatile("" : "+v"(negm)); } \
        const float f = __builtin_amdgcn_exp2f(-dl); l_reg *= f; if (hi == 0) wsf[r32] = f; resc = true; } } \
    SBAR(); \
    GAPB(o[0] = __builtin_amdgcn_mfma_f32_32x32x16_bf16(PAF(0), VFR(0), o[0], 0, 0, 0), C0, 0); \
    GAPB(o[1] = __builtin_amdgcn_mfma_f32_32x32x16_bf16(PAF(0), VFR(4), o[1], 0, 0, 0), C0, 4); \
    KRD(GL, 0); GAPB(o[0] = __builtin_amdgcn_mfma_f32_32x32x16_bf16(PAF(1), VFR(1), o[0], 0, 0, 0), C0, 8); \
    KRD(GL, 1); GAPB(o[1] = __builtin_amdgcn_mfma_f32_32x32x16_bf16(PAF(1), VFR(5), o[1], 0, 0, 0), C0, 12); \
    KRD(GL, 2); GAPB(o[0] = __builtin_amdgcn_mfma_f32_32x32x16_bf16(PAF(2), VFR(2), o[0], 0, 0, 0), C1, 0); \
    KRD(GL, 3); GAPB(o[1] = __builtin_amdgcn_mfma_f32_32x32x16_bf16(PAF(2), VFR(6), o[1], 0, 0, 0), C1, 4); \
    GAPB(o[0] = __builtin_amdgcn_mfma_f32_32x32x16_bf16(PAF(3), VFR(3), o[0], 0, 0, 0), C1, 8); \
    GAPB(o[1] = __builtin_amdgcn_mfma_f32_32x32x16_bf16(PAF(3), VFR(7), o[1], 0, 0, 0), C1, 12); \
    } while (0)
    int t = 1;
    for (; t + 5 < NT; t += 2) {
        STEP(pB0, pB1, pA0, pA1, t, true, true, true);     WAIT_BAR(2); RESC(); ROT();
        STEP(pA0, pA1, pB0, pB1, t + 1, true, true, true); WAIT_BAR(2); RESC(); ROT();
    }
#define ENDW(tt) do { if ((tt) + 3 < NT) { WAIT_BAR(2); } else if ((tt) + 2 < NT) { WAIT_BAR(1); } else { WAIT_BAR(0); } } while (0)
    for (; t + 1 < NT; t += 2) {
        STEP(pB0, pB1, pA0, pA1, t, (t + 3 < NT), (t + 1 < NT), (t + 1 < NT));         ENDW(t);     RESC(); ROT();
        STEP(pA0, pA1, pB0, pB1, t + 1, (t + 4 < NT), (t + 2 < NT), (t + 2 < NT));     ENDW(t + 1); RESC(); ROT();
    }
    STEP(pB0, pB1, pA0, pA1, NT - 1, false, false, false); RESC();
    { float sacc = pB0[0] + pB0[1]; _Pragma("unroll") for (int r = 2; r < 16; ++r) sacc += pB0[r]; _Pragma("unroll") for (int r = 0; r < 16; ++r) sacc += pB1[r]; l_reg += sacc;
      pw0 = (u32x4){PKW(pB0, 0), PKW(pB0, 2), PKW(pB0, 4), PKW(pB0, 6)}; pw1 = (u32x4){PKW(pB0, 8), PKW(pB0, 10), PKW(pB0, 12), PKW(pB0, 14)}; pw2 = (u32x4){PKW(pB1, 0), PKW(pB1, 2), PKW(pB1, 4), PKW(pB1, 6)}; pw3 = (u32x4){PKW(pB1, 8), PKW(pB1, 10), PKW(pB1, 12), PKW(pB1, 14)};
      SBAR(); pv(o, vb0 + sl_cur, PAF(0), PAF(1), PAF(2), PAF(3)); }
#undef PKW
#undef PAF
#undef VFR
#undef PIN
#undef MX3
#undef GAPA
#undef GAPB
#undef EX
#undef VRD
#undef KRD
#undef STEP
#undef ENDW
    { auto rr = __builtin_amdgcn_permlane32_swap(__float_as_uint(l_reg), __float_as_uint(l_reg), false, false); l_reg = __uint_as_float(rr[0]) + __uint_as_float(rr[1]); }
    if (hi == 0) wsf[32 + r32] = l_reg; asm volatile("s_waitcnt lgkmcnt(0)" ::: "memory");
    float rli[16];
#pragma unroll
    for (int r = 0; r < 16; ++r) rli[r] = __builtin_amdgcn_rcpf(wsf[32 + crow(r, hi)]);
    GAS bf16_t* Ow = Ow0 + (long)(wid * QBLK) * QP; const GAS bf16_t* Zw = Zw0 + (long)(wid * QBLK) * QP;
    { __hip_bfloat16* stg = (__hip_bfloat16*)(shm + LDS_OST) + wid * 2048;
#pragma unroll
      for (int r = 0; r < 16; ++r) { const int orow = crow(r, hi);
#pragma unroll
        for (int d0 = 0; d0 < 2; ++d0) stg[orow * 64 + d0 * 32 + r32] = __float2bfloat16(o[d0][r] * rli[r]); }
      asm volatile("s_waitcnt lgkmcnt(0)" ::: "memory");
#pragma unroll
      for (int i = 0; i < 4; ++i) { const int row = i * 8 + (lane >> 3), ch = lane & 7; const u32x4 v = *(const u32x4*)(stg + row * 64 + ch * 8);
        const u32x4 z = *(const GAS u32x4*)(Zw + (long)row * QP + ch * 8); u32x4 y;
        y.x = cvtpk(bflo(v.x) * bflo(z.x), bfhi(v.x) * bfhi(z.x)); y.y = cvtpk(bflo(v.y) * bflo(z.y), bfhi(v.y) * bfhi(z.y));
        y.z = cvtpk(bflo(v.z) * bflo(z.z), bfhi(v.z) * bfhi(z.z)); y.w = cvtpk(bflo(v.w) * bflo(z.w), bfhi(v.w) * bfhi(z.w));
        *(GAS u32x4*)(Ow + (long)row * QP + ch * 8) = y; } }
    asm volatile("s_waitcnt lgkmcnt(0)\n\ts_barrier" ::: "memory");
#undef DMA_K
#undef DMA_V
#undef TMAP
#undef CMASK
#undef START
#undef RESC
#undef ROT
}
#undef SBAR
#undef WAIT_BAR
}

#define XB_TMO      128
#define XB_XCNT(j)  (256  + 64 * (j))
#define XB_XSUB(j)  (1280 + 64 * (j))
#define XB_XGEN(j)  (2304 + 64 * (j))
#define XB_TOP      3328
#define XB_TOPGEN   3392
#define XCD_BAR_WORDS 3456
#define XB_SPIN_CAP (1u << 18)
__device__ __forceinline__ unsigned xb_ld(unsigned* p)              { return __hip_atomic_load(p, __ATOMIC_RELAXED, __HIP_MEMORY_SCOPE_AGENT); }
__device__ __forceinline__ unsigned xb_add(unsigned* p, unsigned v) { return __hip_atomic_fetch_add(p, v, __ATOMIC_RELAXED, __HIP_MEMORY_SCOPE_AGENT); }
__device__ __forceinline__ unsigned xb_xcc_id() { return (unsigned)__builtin_amdgcn_s_getreg((3 << 11) | 20) & 0xFu; }
#define XB_SPIN(cond, bar) do { unsigned _sp = 0; while (cond) { __builtin_amdgcn_s_sleep(1); \
    if ((++_sp & 255u) == 0u) { if (xb_ld(&(bar)[XB_TMO])) break; if (_sp > XB_SPIN_CAP) { atomicAdd(&(bar)[XB_TMO], 1u); break; } } } } while (0)
struct XcdBarrier { unsigned* bar; unsigned x; volatile LAS unsigned* st; };
__device__ __forceinline__ XcdBarrier xcd_barrier_post(unsigned* bar, volatile LAS unsigned* st) {
    XcdBarrier b; b.bar = bar; b.x = xb_xcc_id(); b.st = st;
    if (threadIdx.x == 0) (void)xb_add(&bar[XB_XCNT(b.x)], 1u);
    return b;
}
__device__ __forceinline__ void xcd_barrier_complete(unsigned* bar, unsigned x, unsigned& nloc, unsigned& nx) {
    const unsigned G = gridDim.x * gridDim.y * gridDim.z;
    unsigned sum, cnt, mine, sp = 0u;
    for (;;) {
        sum = 0u; cnt = 0u; mine = 0u;
#pragma unroll
        for (unsigned j = 0; j < 16; ++j) { const unsigned c = xb_ld(&bar[XB_XCNT(j)]); sum += c; cnt += (c > 0u) ? 1u : 0u; mine = (j == x) ? c : mine; }
        if (sum == G) break;
        __builtin_amdgcn_s_sleep(1);
        if ((++sp & 255u) == 0u) { if (xb_ld(&bar[XB_TMO])) break; if (sp > XB_SPIN_CAP) { atomicAdd(&bar[XB_TMO], 1u); break; } }
    }
    nloc = mine > 0u ? mine : 1u; nx = cnt > 0u ? cnt : 1u;
}
__device__ __forceinline__ void xcd_barrier(const XcdBarrier& b) {
    asm volatile("s_waitcnt vmcnt(0)" ::: "memory");
    __syncthreads();
    if (threadIdx.x == 0) {
        unsigned* bar = b.bar;
        __builtin_amdgcn_s_waitcnt(0);
        unsigned nloc = b.st[0], nx = b.st[1];
        if (nloc == 0u) { xcd_barrier_complete(bar, b.x, nloc, nx); b.st[0] = nloc; b.st[1] = nx; }
        const unsigned old = xb_add(&bar[XB_XSUB(b.x)], 1u);
        const unsigned gen = old / nloc;
        if (old + 1u == (gen + 1u) * nloc) {
            __builtin_amdgcn_fence(__ATOMIC_RELEASE, "agent");
            asm volatile("s_waitcnt vmcnt(0)" ::: "memory");
            const unsigned og = xb_add(&bar[XB_TOP], 1u);
            const unsigned tg = og / nx;
            if (og + 1u == (tg + 1u) * nx) xb_add(&bar[XB_TOPGEN], 1u);
            else XB_SPIN(xb_ld(&bar[XB_TOPGEN]) == tg, bar);
            __builtin_amdgcn_fence(__ATOMIC_ACQUIRE, "agent");
            xb_add(&bar[XB_XGEN(b.x)], 1u);
            asm volatile("s_waitcnt vmcnt(0)" ::: "memory");
        } else {
            XB_SPIN(xb_ld(&bar[XB_XGEN(b.x)]) == gen, bar);
            __builtin_amdgcn_fence(__ATOMIC_ACQUIRE, "agent");
            asm volatile("s_waitcnt vmcnt(0)" ::: "memory");
        }
    }
    __syncthreads();
}

__device__ __forceinline__ float wave_sum(float v) {
#pragma unroll
    for (int o = 1; o < 64; o <<= 1) v += __shfl_xor(v, o);
    return v;
}
__device__ __forceinline__ void p0_transpose_item(const float* W, int K, int N, bf16_t* WT, LAS float* scr, int item, int lane) {
    const int nblk = N / 32, kb = item / nblk, nb = item % nblk, k0 = 64 * kb, n0 = 32 * nb;
#pragma unroll 8
    for (int i = 0; i < 32; ++i) { const int kk = 2 * i + (lane >> 5); scr[kk * 33 + (lane & 31)] = W[(size_t)(k0 + kk) * N + n0 + (lane & 31)]; }
    LDS_WAIT(); asm volatile("" ::: "memory");
    const int c = lane & 7;
#pragma unroll
    for (int j = 0; j < 4; ++j) { const int n = (lane >> 3) + 8 * j; const LAS float* s = scr + (8 * c) * 33 + n;
        u32x4 o; o.x = cvtpk(s[0 * 33], s[1 * 33]); o.y = cvtpk(s[2 * 33], s[3 * 33]); o.z = cvtpk(s[4 * 33], s[5 * 33]); o.w = cvtpk(s[6 * 33], s[7 * 33]);
        *(GAS u32x4*)(WT + (size_t)(n0 + n) * K + k0 + 8 * c) = o; }
    LDS_WAIT(); asm volatile("" ::: "memory");
}

struct Args { const float* in[16]; float* out; unsigned char* ws; };

__device__ __forceinline__ void p1_rows(const GAS float* x, const GAS float* cx, const GAS float* g, const GAS float* mod, GAS bf16_t* HX, int gw, int NGW, int lane) {
    for (int m = gw; m < MT; m += NGW) {
        const bool isc = m >= ML;
        const GAS float* xrow = isc ? cx + (size_t)(m - ML) * DM : x + (size_t)m * DM;
        const GAS float* md = mod + (isc ? 4 : (m >> 12)) * 3072;
        const GAS f32x4* xr = (const GAS f32x4*)xrow + lane;
        f32x4 v[4]; float s = 0.f;
#pragma unroll
        for (int j = 0; j < 4; ++j) { v[j] = xr[64 * j]; s += (v[j].x * v[j].x + v[j].y * v[j].y) + (v[j].z * v[j].z + v[j].w * v[j].w); }
        const float r = __builtin_amdgcn_rsqf(wave_sum(s) * (1.f / DM) + EPS);
        GAS unsigned long long* o8 = (GAS unsigned long long*)(HX + (size_t)m * DM) + lane;
#pragma unroll
        for (int j = 0; j < 4; ++j) {
            const f32x4 gg = *((const GAS f32x4*)g + lane + 64 * j), sh = *((const GAS f32x4*)md + lane + 64 * j), sc = *((const GAS f32x4*)(md + 1024) + lane + 64 * j);
            const f32x4 y = v[j] * r * gg * (sc + 1.0f) + sh;
            o8[64 * j] = (unsigned long long)cvtpk(y.x, y.y) | ((unsigned long long)cvtpk(y.z, y.w) << 32);
        }
    }
}

__global__ void __launch_bounds__(NWAVES * 64, 2) dit_fwd(Args args) {
    extern __shared__ __attribute__((aligned(16))) unsigned char lds_raw[];
    LAS unsigned char* lds = (LAS unsigned char*)lds_raw;
    volatile LAS unsigned* MISC = (volatile LAS unsigned*)(lds + MISC_OFF);
    const int tid = threadIdx.x, lane = tid & 63, wave = __builtin_amdgcn_readfirstlane(tid >> 6);
    const int G = gridDim.x; const int bx = blockIdx.x; const int vcu = (G % 8 == 0) ? (bx % 8) * (G / 8) + bx / 8 : bx;
    unsigned char* ws = args.ws;
    unsigned* ctl = (unsigned*)(ws + WS_CTL);
    for (int u = tid; u < (LDS_BYTES - LDSCTL_OFF) / 4; u += NWAVES * 64) ((LAS unsigned*)(lds + LDSCTL_OFF))[u] = 0u;
    __syncthreads();
    XcdBarrier bar = xcd_barrier_post(ctl + CW_BAR, MISC + 8);

    float* out = args.out;
    const int gw = vcu * NWAVES + wave, NGW = G * NWAVES;

    {
        const float* c_in = args.in[1]; const float* cctx = args.in[3]; const float* w_ada = args.in[4]; const float* b_ada = args.in[5];
        float* MOD = (float*)(ws + WS_MOD); float* ROPE = (float*)(ws + WS_ROPE); float* NWT = (float*)(ws + WS_NW);
        for (int task = vcu; task < 193; task += G) if (task < 192) {
            LAS float* sc = (LAS float*)lds;
            LAS float* red = (LAS float*)(lds + 20480);
            for (int i = tid; i < 5 * 1024; i += NWAVES * 64) { const float cv = (i < 4096) ? c_in[i] : cctx[i - 4096]; sc[i] = cv * fsigmoid(cv); }
            __syncthreads();
            const int l = task / 96, n0 = (task % 96) * 32, col = lane & 31, kh = lane >> 5;
            const float* wp = w_ada + (size_t)l * 1024 * 3072 + n0 + col;
            float a0 = 0.f, a1 = 0.f, a2 = 0.f, a3 = 0.f, a4 = 0.f;
            const int kbase = 128 * wave + 64 * kh;
#pragma unroll 8
            for (int i = 0; i < 64; ++i) { const int k = kbase + i; const float wv = wp[(size_t)k * 3072];
                a0 += sc[k] * wv; a1 += sc[1024 + k] * wv; a2 += sc[2048 + k] * wv; a3 += sc[3072 + k] * wv; a4 += sc[4096 + k] * wv; }
            const int slot = wave * 2 + kh;
            red[(slot * 5 + 0) * 32 + col] = a0; red[(slot * 5 + 1) * 32 + col] = a1; red[(slot * 5 + 2) * 32 + col] = a2; red[(slot * 5 + 3) * 32 + col] = a3; red[(slot * 5 + 4) * 32 + col] = a4;
            __syncthreads();
            if (tid < 160) { const int r = tid >> 5, cc = tid & 31; float sm = 0.f;
                for (int sl = 0; sl < 16; ++sl) sm += red[(sl * 5 + r) * 32 + cc];
                MOD[(size_t)(l * 5 + r) * 3072 + n0 + cc] = sm + b_ada[l * 3072 + n0 + cc]; }
            __syncthreads();
        } else {
            for (int i = tid; i < 64 * 16; i += NWAVES * 64) { const int pos = i >> 4, j = i & 15;
                const float inv = 1.0f / powf(10000.0f, (float)j / 16.0f); const float ang = (float)pos * inv;
                ROPE[2 * i] = cosf(ang); ROPE[2 * i + 1] = sinf(ang); }
            if (tid < 512) { const int l = tid >> 8, w = (tid >> 6) & 3, d = tid & 63; NWT[tid] = args.in[8 + w][l * 64 + d]; }
        }
        const float* w_in = args.in[7]; const float* w_o_a = args.in[13]; const float* w_o_b = args.in[14]; const float* w_out = args.in[15];
        bf16_t* WIN = (bf16_t*)(ws + WS_WIN); bf16_t* WOA = (bf16_t*)(ws + WS_WOA); bf16_t* WOB = (bf16_t*)(ws + WS_WOB); bf16_t* WOUT = (bf16_t*)(ws + WS_WOUT);
        LAS float* scr = (LAS float*)(lds + 32768 + wave * 8704);
        constexpr int I_IN = (DM / 64) * (INC / 32), I_O = (512 / 64) * (DM / 32), I_OUT = (DM / 64) * (DM / 32), I_L = I_IN + 2 * I_O + I_OUT;
        for (int it = gw; it < 2 * I_L; it += NGW) {
            const int l = it / I_L; int r = it % I_L;
            if (r < I_IN) { p0_transpose_item(w_in + (size_t)l * DM * INC, DM, INC, WIN + (size_t)l * INC * DM, scr, r, lane); continue; } r -= I_IN;
            if (r < I_O) { p0_transpose_item(w_o_a + (size_t)l * 512 * DM, 512, DM, WOA + (size_t)l * DM * 512, scr, r, lane); continue; } r -= I_O;
            if (r < I_O) { p0_transpose_item(w_o_b + (size_t)l * 512 * DM, 512, DM, WOB + (size_t)l * DM * 512, scr, r, lane); continue; } r -= I_O;
            p0_transpose_item(w_out + (size_t)l * DM * DM, DM, DM, WOUT + (size_t)l * DM * DM, scr, r, lane);
        }
    }
    xcd_barrier(bar);

    for (int layer = 0; layer < 2; ++layer) {
        const bool upd = (layer == 0);
        const int nM = upd ? 68 : 64;
        {
            gptr wl = launder(ws);
            const GAS float* xl = layer == 0 ? (const GAS float*)args.in[0] : (const GAS float*)out;
            const GAS float* cl = layer == 0 ? (const GAS float*)args.in[2] : (const GAS float*)(wl + WS_CTXN);
            p1_rows(xl, cl, (const GAS float*)args.in[6] + layer * DM, (const GAS float*)(wl + WS_MOD) + (size_t)layer * 5 * 3072, (GAS bf16_t*)(wl + WS_HX), gw, NGW, lane);
        }
        xcd_barrier(bar);
        {
            InProj p; p.ws = ws; p.layer = layer; p.nM = nM; p.nmain = nM * 21; p.nextra = upd ? 0 : 20; p.G = G; p.c = bx;
            pg8::gemm_phase<InProj, DM>(lds, p);
        }
        xcd_barrier(bar);
        {
            char* shm = (char*)lds_raw;
            for (int ug = vcu; ug < 512; ug += G) {
                const int i = ug >> 8, x8 = (ug >> 5) & 7, j = ug & 31;
                const int b = x8 >> 1, kh = x8 & 1, h = kh * 4 + (j >> 3), qb = (j & 7) * 2 + i;
                const size_t qoff = ((size_t)b * SEQ + qb * 256) * QP + h * 64; const size_t koff = (size_t)b * KVR * 128 + kh * 64;
                gptr wl = launder(ws);
                GAS bf16_t* QB = (GAS bf16_t*)(wl + WS_QB); const GAS bf16_t* KB = (const GAS bf16_t*)(wl + WS_KB); const GAS bf16_t* VB = (const GAS bf16_t*)(wl + WS_VB); const GAS bf16_t* SZB = (const GAS bf16_t*)(wl + WS_SZB);
                attn_body::attn_unit<0, 128, 8>(QB + qoff, KB + koff, VB + koff, KVR / 64, 0, QB + qoff, SZB + qoff, 0, (const GAS float*)nullptr, shm);
            }
            for (int un = vcu; un < 512; un += G) {
                const int i = un >> 8, x8 = (un >> 5) & 7, j = un & 31;
                const int bh = x8 * 4 + (j >> 3), b = bh >> 3, h = bh & 7, qb = (j & 7) * 2 + i;
                int lo = 4 * qb - 4; lo = lo < 0 ? 0 : (lo > 56 ? 56 : lo);
                int hi = 4 * qb - 1; hi = hi < 0 ? 0 : (hi > 56 ? 56 : hi); hi += 7;
                int nrow = hi - lo + 1; if (nrow & 1) { if (hi < 63) ++nrow; else { --lo; ++nrow; } }
                const size_t qoff = ((size_t)b * SEQ + qb * 256) * QP + h * 64; const size_t koff = (size_t)b * KVR * 512 + h * 64;
                gptr wl = launder(ws);
                GAS bf16_t* QA = (GAS bf16_t*)(wl + WS_QA); const GAS bf16_t* KA = (const GAS bf16_t*)(wl + WS_KA); const GAS bf16_t* VA = (const GAS bf16_t*)(wl + WS_VA); const GAS bf16_t* SZA = (const GAS bf16_t*)(wl + WS_SZA);
                attn_body::attn_unit<1, 512, 8>(QA + qoff, KA + koff, VA + koff, 4 + nrow, lo, QA + qoff, SZA + qoff, 4 * qb, (const GAS float*)args.in[12] + ((size_t)layer * 8 + h) * 15 * 31, shm);
            }
            if (upd) for (int uc = vcu; uc < 256; uc += G) if ((uc & 3) == 0) {
                const int id = uc >> 2, br = id >> 5, bh = id & 31, b = bh >> 3, h = bh & 7;
                const size_t qoff = ((size_t)ML + b * CTXL) * QP + h * 64;
                gptr wl = launder(ws);
                if (br == 0) { const size_t koff = (size_t)b * KVR * 512 + h * 64;
                    GAS bf16_t* QA = (GAS bf16_t*)(wl + WS_QA); const GAS bf16_t* KA = (const GAS bf16_t*)(wl + WS_KA); const GAS bf16_t* VA = (const GAS bf16_t*)(wl + WS_VA); const GAS bf16_t* SZA = (const GAS bf16_t*)(wl + WS_SZA);
                    attn_body::attn_unit<0, 512, 8>(QA + qoff, KA + koff, VA + koff, 4, 0, QA + qoff, SZA + qoff, 0, (const GAS float*)nullptr, shm); }
                else { const size_t koff = (size_t)b * KVR * 128 + (h >> 2) * 64;
                    GAS bf16_t* QB = (GAS bf16_t*)(wl + WS_QB); const GAS bf16_t* KB = (const GAS bf16_t*)(wl + WS_KB); const GAS bf16_t* VB = (const GAS bf16_t*)(wl + WS_VB); const GAS bf16_t* SZB = (const GAS bf16_t*)(wl + WS_SZB);
                    attn_body::attn_unit<0, 128, 8>(QB + qoff, KB + koff, VB + koff, 4, 0, QB + qoff, SZB + qoff, 0, (const GAS float*)nullptr, shm); }
            }
        }
        xcd_barrier(bar);
        {
            MergeProj p; p.ws = ws; p.layer = layer; p.nM = nM; p.G = G; p.c = bx;
            pg8::gemm_phase<MergeProj, 512>(lds, p);
        }
        xcd_barrier(bar);
        {
            OutProj p; p.ws = ws; p.layer = layer; p.xin = layer == 0 ? (const GAS float*)args.in[0] : (const GAS float*)out; p.xout = (GAS float*)out; p.cin = layer == 0 ? (const GAS float*)args.in[2] : (const GAS float*)(ws + WS_CTXN); p.nM = nM; p.G = G; p.c = bx;
            pg8::gemm_phase<OutProj, DM>(lds, p);
        }
        if (layer == 0) xcd_barrier(bar);
    }
}

extern "C" void kernel_launch(void* const* d_in, const int* in_sizes, int n_in, void* d_out, int out_size, void* d_ws, size_t ws_size, hipStream_t stream) {
    static int grid = 0;
    if (grid == 0) {
        if (n_in != 16 || out_size != ML * DM || ws_size < WS_END) { fprintf(stderr, "kernel_launch: unexpected problem (n_in %d out %d ws %zu)\n", n_in, out_size, ws_size); grid = -1; return; }
        int dev = 0, cus = 0, per_cu = 0;
        if (hipGetDevice(&dev) != hipSuccess || hipDeviceGetAttribute(&cus, hipDeviceAttributeMultiprocessorCount, dev) != hipSuccess) { grid = -1; return; }
        if (hipFuncSetAttribute((const void*)dit_fwd, hipFuncAttributeMaxDynamicSharedMemorySize, LDS_BYTES) != hipSuccess) { fprintf(stderr, "kernel_launch: hipFuncSetAttribute failed\n"); grid = -1; return; }
        if (hipOccupancyMaxActiveBlocksPerMultiprocessor(&per_cu, (const void*)dit_fwd, NWAVES * 64, LDS_BYTES) != hipSuccess || per_cu < 1) { fprintf(stderr, "kernel_launch: occupancy query says %d\n", per_cu); per_cu = 1; }
        (void)hipGetLastError();
        grid = cus;
        if (grid != 256) fprintf(stderr, "kernel_launch: %d CUs; the static unit maps assume 256\n", grid);
    }
    if (grid < 0) return;
    (void)hipMemsetAsync((char*)d_ws + WS_CTL, 0, CTL_ZERO_BYTES, stream);
    Args a{};
    for (int i = 0; i < 16; ++i) a.in[i] = (const float*)d_in[i];
    a.out = (float*)d_out; a.ws = (unsigned char*)d_ws;
    hipLaunchKernelGGL(dit_fwd, dim3(grid), dim3(NWAVES * 64), LDS_BYTES, stream, a);
}
```

```cpp
#include <hip/hip_runtime.h>
#include <hip/hip_bf16.h>
#include <cstdio>
#include <cstdint>
#include <cmath>

#define LAS __attribute__((address_space(3)))
#define GAS __attribute__((address_space(1)))
typedef unsigned short bf16_t;
typedef short bf16x8 __attribute__((ext_vector_type(8)));
typedef short s16x4 __attribute__((ext_vector_type(4)));
typedef float f32x4 __attribute__((ext_vector_type(4)));
typedef float f32x16 __attribute__((ext_vector_type(16)));
typedef unsigned u32x4 __attribute__((ext_vector_type(4)));
typedef float f32x2_t __attribute__((ext_vector_type(2)));
typedef __bf16 bf16x2_t __attribute__((ext_vector_type(2)));

constexpr int DM = 1024, NB = 4, SEQ = 4096, CTXL = 256, HD = 64;
constexpr int ML = NB * SEQ;
constexpr int MC = NB * CTXL;
constexpr int MT = ML + MC;
constexpr int INC = 5376;
constexpr int KVR = CTXL + SEQ;
constexpr int QP = 512;
constexpr float EPS = 1e-6f;
constexpr float LOG2E = 1.4426950408889634f;
constexpr float C2 = 0.125f * LOG2E;

constexpr size_t MiB = 1u << 20;
constexpr size_t WS_CTL = 0, CTL_ZERO_BYTES = 128 * 1024;
constexpr size_t WS_MOD = 1 * MiB;
constexpr size_t WS_ROPE = 1 * MiB + 256 * 1024;
constexpr size_t WS_NW = 1 * MiB + 512 * 1024;
constexpr size_t WS_WIN = 2 * MiB;
constexpr size_t WS_WOA = 23 * MiB;
constexpr size_t WS_WOB = 25 * MiB;
constexpr size_t WS_WOUT = 27 * MiB;
constexpr size_t WS_CTXN = 31 * MiB;
constexpr size_t WS_HX = 36 * MiB;
constexpr size_t WS_KA = 70 * MiB;
constexpr size_t WS_VA = 87 * MiB;
constexpr size_t WS_KB = 104 * MiB;
constexpr size_t WS_VB = 109 * MiB;
constexpr size_t WS_QA = 114 * MiB;
constexpr size_t WS_QB = 131 * MiB;
constexpr size_t WS_SZA = 148 * MiB;
constexpr size_t WS_SZB = 165 * MiB;
constexpr size_t WS_SGA = 182 * MiB;
constexpr size_t WS_SGB = 216 * MiB;
constexpr size_t WS_END = 250 * MiB;
constexpr size_t WS_YA = WS_HX, WS_YB = WS_HX + 17 * MiB;
constexpr size_t WS_MG = WS_QA;
constexpr size_t WS_YCA = 250 * MiB, WS_YCB = 251 * MiB;
constexpr size_t WS_MGC = 252 * MiB;
constexpr size_t WS_USED = 254 * MiB;
constexpr int CW_BAR = 4096;
constexpr size_t WS_XB = 1 * MiB + 768 * 1024;
constexpr int CW_CNT = 16384;

constexpr int RING_BYTES = 131072;
constexpr int LDSCTL_OFF = RING_BYTES, MISC_OFF = LDSCTL_OFF + 320;
constexpr int LDS_BYTES = 147456;
constexpr int NWAVES = 8;

#define LDS_WAIT() asm volatile("s_waitcnt lgkmcnt(0)" ::: "memory")
#define VM_WAIT() asm volatile("s_waitcnt vmcnt(0)" ::: "memory")

__device__ __forceinline__ unsigned cvtpk(float lo, float hi) { f32x2_t v = {lo, hi}; bf16x2_t b = __builtin_convertvector(v, bf16x2_t); return __builtin_bit_cast(unsigned, b); }
__device__ __forceinline__ float sum_fq(float x) {
    auto a = __builtin_amdgcn_permlane16_swap(__float_as_uint(x), __float_as_uint(x), false, false); x = __uint_as_float(a[0]) + __uint_as_float(a[1]);
    auto b = __builtin_amdgcn_permlane32_swap(__float_as_uint(x), __float_as_uint(x), false, false); return __uint_as_float(b[0]) + __uint_as_float(b[1]); }
__device__ __forceinline__ float bflo(unsigned u) { return __builtin_bit_cast(float, u << 16); }
__device__ __forceinline__ float bfhi(unsigned u) { return __builtin_bit_cast(float, u & 0xffff0000u); }
typedef GAS unsigned char* gptr;
__device__ __forceinline__ gptr launder(unsigned char* p) { asm volatile("" : "+s"(p)); return (gptr)p; }
__device__ __forceinline__ float fsigmoid(float v) { return __builtin_amdgcn_rcpf(1.0f + __builtin_amdgcn_exp2f(-v * LOG2E)); }

namespace pg8 {
constexpr int BM = 256, BK = 64, HALF = 128, HTB = HALF * BK * 2, NXCD = 8, WGM = 8;
__host__ __device__ __forceinline__ int lds_byte(int r, int c) { const int st = (r >> 4) * 2 + (c >> 5), rr = r & 15, cc = c & 31, ob = rr * 64 + cc * 2; return st * 1024 + (ob ^ (((ob >> 9) & 1) << 5)); }
__host__ __device__ __forceinline__ void stage_rc(int b, int& R, int& C) { const int st = b / 1024, sb = b % 1024, swz = sb ^ (((sb >> 9) & 1) << 5); R = (st >> 1) * 16 + swz / 64; C = (st & 1) * 32 + (swz % 64) / 2; }
__host__ __device__ __forceinline__ int perm32(int rho) { const int n = rho >> 4, i = rho & 15; return 8 * (i >> 2) + 4 * n + (i & 3); }

struct Unit { int pm, pn, sub; };

__device__ __forceinline__ void tile_of(int L, int nM, int nN, int& pm, int& pn) {
    const int nwg = nM * nN; int wgid = L;
    { const int q = nwg / NXCD, r = nwg % NXCD, xcd = wgid % NXCD, off = wgid / NXCD; wgid = (xcd < r ? xcd * (q + 1) : r * (q + 1) + (xcd - r) * q) + off; }
    const int nig = WGM * nN, gid = wgid / nig, fm = gid * WGM, gsz = (nM - fm) < WGM ? (nM - fm) : WGM;
    pm = fm + ((wgid % nig) % gsz); pn = (wgid % nig) / gsz;
}

template <class P, int K>
__device__ __forceinline__ void gemm_phase(LAS unsigned char* lds, const P& p) {
    int tid_ = threadIdx.x; asm volatile("" : "+v"(tid_));
    const int tid = tid_, wid = __builtin_amdgcn_readfirstlane(tid >> 6), lane = tid & 63, wr = wid >> 2, wc = wid & 3, fr = lane & 15, fq = lane >> 4;
    constexpr int nt = K / BK;
    unsigned voffA[2], voffB[2];
#pragma unroll
    for (int i = 0; i < 2; ++i) { int R, C; stage_rc(tid * 16 + i * 8192, R, C); const int Rb = P::brow(R);
        voffA[i] = (unsigned)(R * K + C) * 2u; voffB[i] = (unsigned)(Rb * K + C) * 2u; }
    constexpr size_t kstep = (size_t)(BK * 2);
    constexpr size_t hstepA = (size_t)HALF * K * 2;
    const unsigned ldsw = (unsigned)wid * 1024u;
    const int aoff = lds_byte(wr * 64 + fr, fq * 8), boff = lds_byte(wc * 32 + fr, fq * 8);
#define PG8_SA(b, h) (((b) * 2 + (h)) * HTB)
#define PG8_SB(b, h) ((4 + (b) * 2 + (h)) * HTB)
#define PG8_STAGE(bufoff, gbase, voff) do { _Pragma("unroll") for (int _i = 0; _i < 2; ++_i) \
        __builtin_amdgcn_global_load_lds((const unsigned*)((const char*)(gbase) + (voff)[_i]), (LAS unsigned*)(lds + (bufoff) + ldsw + _i * 8192), 16, 0, 0); } while (0)
#define PG8_LDA(dst, b, h) do { _Pragma("unroll") for (int m = 0; m < 4; ++m) _Pragma("unroll") for (int k = 0; k < 2; ++k) dst[m][k] = *(const LAS bf16x8*)(lds + PG8_SA(b, h) + aoff + m * 2048 + k * 1024); } while (0)
#define PG8_LDB(dst, b, h) do { _Pragma("unroll") for (int n = 0; n < 2; ++n) _Pragma("unroll") for (int k = 0; k < 2; ++k) dst[n][k] = *(const LAS bf16x8*)(lds + PG8_SB(b, h) + boff + n * 2048 + k * 1024); } while (0)
#define PG8_MMA(ai, bj, At, Bt) do { __builtin_amdgcn_s_setprio(1); _Pragma("unroll") for (int m = 0; m < 4; ++m) _Pragma("unroll") for (int n = 0; n < 2; ++n) _Pragma("unroll") for (int k = 0; k < 2; ++k) \
        acc[ai][bj][m][n] = __builtin_amdgcn_mfma_f32_16x16x32_bf16(Bt[n][k], At[m][k], acc[ai][bj][m][n], 0, 0, 0); __builtin_amdgcn_s_setprio(0); } while (0)
#define PG8_WAIT_V(n) asm volatile("s_waitcnt vmcnt(" #n ")" ::: "memory")
#define PG8_WAIT_L(n) asm volatile("s_waitcnt lgkmcnt(" #n ")" ::: "memory")
#define PG8_BAR __builtin_amdgcn_s_barrier()
#define PG8_SCHED __builtin_amdgcn_sched_barrier(0)
    Unit cur, nxt; int ui = 0;
    if (!p.next(0, cur)) return;
    f32x4 acc[2][2][4][2];
#pragma unroll
    for (int a = 0; a < 2; ++a)
#pragma unroll
        for (int b = 0; b < 2; ++b)
#pragma unroll
            for (int m = 0; m < 4; ++m)
#pragma unroll
                for (int n = 0; n < 2; ++n) acc[a][b][m][n] = (f32x4){0.f, 0.f, 0.f, 0.f};
    bf16x8 At[4][2], B0[2][2], B1[2][2];
    p.a_ready(cur);
    const char* cA = p.aptr(cur); const char* cB = p.bptr(cur);
    size_t hsC = p.bhalf(cur) * (size_t)(K * 2), hsN = hsC;
    PG8_STAGE(PG8_SB(0, 0), cB, voffB); PG8_STAGE(PG8_SB(0, 1), cB + hsC, voffB); PG8_STAGE(PG8_SA(0, 0), cA, voffA); PG8_STAGE(PG8_SA(0, 1), cA + hstepA, voffA);
    if (wr == 1) PG8_BAR;
    PG8_WAIT_V(2); PG8_BAR;
    PG8_STAGE(PG8_SB(1, 0), cB + kstep, voffB); PG8_STAGE(PG8_SA(1, 0), cA + kstep, voffA); PG8_STAGE(PG8_SB(1, 1), cB + hsC + kstep, voffB);
    PG8_WAIT_V(6); PG8_BAR;
    for (;;) {
        const bool has_next = p.next(ui + 1, nxt);
        const char* nA = has_next ? p.aptr(nxt) : cA; const char* nB = has_next ? p.bptr(nxt) : cB; hsN = has_next ? p.bhalf(nxt) * (size_t)(K * 2) : hsC;
        for (int t = 0; t < nt; t += 2) {
            const bool last = (t == nt - 2);
            const char* a1 = cA + (size_t)(t + 1) * kstep;
            const char* a2 = last ? nA : cA + (size_t)(t + 2) * kstep; const char* b2 = last ? nB : cB + (size_t)(t + 2) * kstep;
            const char* a3 = a2 + kstep; const char* b3 = b2 + kstep; const size_t hs2 = last ? hsN : hsC;
            if (last && has_next) p.a_ready(nxt);
            PG8_LDB(B0, 0, 0); PG8_LDB(B1, 0, 1); PG8_SCHED; PG8_LDA(At, 0, 0); PG8_STAGE(PG8_SA(1, 1), a1 + hstepA, voffA);
            PG8_WAIT_V(8); PG8_WAIT_L(0); PG8_BAR; PG8_MMA(0, 0, At, B0); PG8_MMA(0, 1, At, B1); PG8_BAR; PG8_SCHED;
            PG8_LDA(At, 0, 1); PG8_STAGE(PG8_SB(0, 0), b2, voffB); PG8_STAGE(PG8_SB(0, 1), b2 + hs2, voffB); PG8_STAGE(PG8_SA(0, 0), a2, voffA);
            PG8_WAIT_V(8); PG8_WAIT_L(0); PG8_BAR; PG8_MMA(1, 0, At, B0); PG8_MMA(1, 1, At, B1); PG8_BAR; PG8_SCHED;
            PG8_LDB(B0, 1, 0); PG8_LDB(B1, 1, 1); PG8_SCHED; PG8_LDA(At, 1, 0); PG8_STAGE(PG8_SA(0, 1), a2 + hstepA, voffA);
            PG8_WAIT_V(8); PG8_WAIT_L(0); PG8_BAR; PG8_MMA(0, 0, At, B0); PG8_MMA(0, 1, At, B1); PG8_BAR; PG8_SCHED;
            PG8_LDA(At, 1, 1); PG8_STAGE(PG8_SB(1, 0), b3, voffB); PG8_STAGE(PG8_SB(1, 1), b3 + hs2, voffB); PG8_STAGE(PG8_SA(1, 0), a3, voffA);
            PG8_WAIT_V(8); PG8_WAIT_L(0); PG8_BAR; PG8_MMA(1, 0, At, B0); PG8_MMA(1, 1, At, B1); PG8_BAR; PG8_SCHED;
        }
        if (wr == 0) PG8_BAR;
        if constexpr (!P::AFTER_DRAIN) p.epi(acc, cur, wr, wc, fr, fq);
        if (!has_next) break;
        if (!p.keep(cur)) {
#pragma unroll
            for (int a = 0; a < 2; ++a)
#pragma unroll
                for (int b = 0; b < 2; ++b)
#pragma unroll
                    for (int m = 0; m < 4; ++m)
#pragma unroll
                        for (int n = 0; n < 2; ++n) acc[a][b][m][n] = (f32x4){0.f, 0.f, 0.f, 0.f};
        }
        cur = nxt; cA = nA; cB = nB; hsC = hsN; ++ui;
        if (wr == 1) PG8_BAR;
    }
    PG8_WAIT_V(0);
    PG8_BAR;
    if constexpr (P::AFTER_DRAIN) p.epi_drain(acc, cur, wr, wc, fr, fq, lds, wid, lane);
#undef PG8_SA
#undef PG8_SB
#undef PG8_STAGE
#undef PG8_LDA
#undef PG8_LDB
#undef PG8_MMA
#undef PG8_WAIT_V
#undef PG8_WAIT_L
#undef PG8_BAR
#undef PG8_SCHED
}
}

struct InProj {
    static constexpr int BHALF_ROWS = 16; static constexpr bool AFTER_DRAIN = false;
    __host__ __device__ static int brow(int R) { return 64 * (R >> 5) + 8 * (((R >> 2) & 1) + 4 * ((R >> 3) & 1)) + 4 * ((R >> 4) & 1) + (R & 3); }
    unsigned char* ws; int layer;
    int ctx_extra; unsigned* wcnt; unsigned wneed;
    int nM, nmain, G, c, i0, i1, single, extraL;
    __device__ __forceinline__ bool next(int i, pg8::Unit& u) const {
        u.sub = 0;
        if (single >= 0) { if (i != 0) return false; u.pm = 64 + single / 5; u.pn = single % 5; return true; }
        int nr = (nmain - c + G - 1) / G; nr = (nr < i1 ? nr : i1) - i0; nr = nr < 0 ? 0 : nr;
        int L;
        if (i < nr) L = (i + i0) * G + c; else if (i == nr && extraL >= 0) L = extraL;
        else if (ctx_extra >= 0 && i == nr + (extraL >= 0 ? 1 : 0)) { u.pm = 64 + ctx_extra / 5; u.pn = ctx_extra % 5; return true; }
        else return false;
        pg8::tile_of(L, nM, 21, u.pm, u.pn); return true;
    }
    __device__ __forceinline__ const char* aptr(const pg8::Unit& u) const { return (const char*)(ws + WS_HX) + (size_t)u.pm * 256 * DM * 2; }
    __device__ __forceinline__ const char* bptr(const pg8::Unit& u) const { const int cb = u.pn < 13 ? u.pn * 256 : 3328 + 256 * ((u.pn - 13) >> 1) + 16 * ((u.pn - 13) & 1);
        return (const char*)(ws + WS_WIN) + ((size_t)layer * INC + (size_t)cb) * DM * 2; }
    __device__ __forceinline__ size_t bhalf(const pg8::Unit& u) const { return u.pn < 13 ? 16 : 1024; }
    __device__ __forceinline__ void a_ready(const pg8::Unit& u) const {
        if (ctx_extra < 0 || u.pm < 64) return;
        if (threadIdx.x < 64) { unsigned sp = 0;
            while ((unsigned)__builtin_amdgcn_readfirstlane(__hip_atomic_load(wcnt, __ATOMIC_RELAXED, __HIP_MEMORY_SCOPE_AGENT)) < wneed) { __builtin_amdgcn_s_sleep(2); if (++sp > (1u << 22)) break; }
            __builtin_amdgcn_fence(__ATOMIC_ACQUIRE, "agent");
            asm volatile("s_waitcnt vmcnt(0)" ::: "memory"); }
        asm volatile("" ::: "memory"); __builtin_amdgcn_s_barrier(); asm volatile("" ::: "memory");
    }
    __device__ __forceinline__ bool keep(const pg8::Unit&) const { return false; }
    __device__ __forceinline__ void epi(f32x4 (&acc)[2][2][4][2], const pg8::Unit& u, int wr, int wc, int fr, int fq) const {
        const int pn = u.pn, pm = u.pm;
        gptr wl = launder(ws);
        GAS bf16_t* KA = (GAS bf16_t*)(wl + WS_KA); GAS bf16_t* VA = (GAS bf16_t*)(wl + WS_VA); GAS bf16_t* KB = (GAS bf16_t*)(wl + WS_KB); GAS bf16_t* VB = (GAS bf16_t*)(wl + WS_VB);
        GAS bf16_t* QA = (GAS bf16_t*)(wl + WS_QA); GAS bf16_t* QB = (GAS bf16_t*)(wl + WS_QB); GAS bf16_t* SZA = (GAS bf16_t*)(wl + WS_SZA); GAS bf16_t* SZB = (GAS bf16_t*)(wl + WS_SZB);
        GAS bf16_t* SGA = (GAS bf16_t*)(wl + WS_SGA); GAS bf16_t* SGB = (GAS bf16_t*)(wl + WS_SGB);
        const GAS float* nwt = (const GAS float*)(wl + WS_NW) + layer * 256; const GAS float* qna = nwt; const GAS float* kna = nwt + 64; const GAS float* qnb = nwt + 128; const GAS float* knb = nwt + 192;
        const GAS float* rope = (const GAS float*)(wl + WS_ROPE);
        const bool ctxrow = pm >= 64;
        const int kv0 = ctxrow ? (pm - 64) * KVR : ((pm >> 4) * KVR + CTXL + (pm & 15) * 256);
        const int c0 = (fq & 1) + 4 * (fq >> 1);
        const int hcol = 64 * wc;
        int type; GAS bf16_t* dst; int pitch, rowbase; const GAS float* nw = nullptr; bool rope_on = false; float osc = 1.f;
        if (pn < 2)       { type = 1; dst = KA + pn * 256 + hcol; pitch = 512; rowbase = kv0; nw = kna; }
        else if (pn < 4)  { type = 0; dst = VA + (pn - 2) * 256 + hcol; pitch = 512; rowbase = kv0; }
        else if (pn == 4) { if (wc < 2) { type = 1; dst = KB + hcol; pitch = 128; rowbase = kv0; nw = knb; rope_on = !ctxrow; }
                            else        { type = 0; dst = VB + (hcol - 128); pitch = 128; rowbase = kv0; } }
        else if (pn < 7)  { type = 1; dst = QA + (pn - 5) * 256 + hcol; pitch = QP; rowbase = pm * 256; nw = qna; osc = C2; }
        else if (pn < 9)  { type = 1; dst = QB + (pn - 7) * 256 + hcol; pitch = QP; rowbase = pm * 256; nw = qnb; rope_on = !ctxrow; osc = C2; }
        else if (pn < 11) { type = 2; dst = SZA + (pn - 9) * 256 + hcol; pitch = QP; rowbase = pm * 256; }
        else if (pn < 13) { type = 2; dst = SZB + (pn - 11) * 256 + hcol; pitch = QP; rowbase = pm * 256; }
        else              { type = 3; dst = SGA + 256 * ((pn - 13) >> 1) + 16 * ((pn - 13) & 1) + hcol; pitch = DM; rowbase = pm * 256; }
        float w[2][8];
        if (type == 1) {
#pragma unroll
            for (int bj = 0; bj < 2; ++bj) { const f32x4 a = *(const GAS f32x4*)(nw + 8 * (c0 + 2 * bj)), b = *(const GAS f32x4*)(nw + 8 * (c0 + 2 * bj) + 4);
                w[bj][0] = a[0] * osc; w[bj][1] = a[1] * osc; w[bj][2] = a[2] * osc; w[bj][3] = a[3] * osc; w[bj][4] = b[0] * osc; w[bj][5] = b[1] * osc; w[bj][6] = b[2] * osc; w[bj][7] = b[3] * osc; }
        }
#pragma unroll
        for (int ai = 0; ai < 2; ++ai)
#pragma unroll
            for (int m = 0; m < 4; ++m) {
                const int rr = 128 * ai + 64 * wr + 16 * m + fr;
                float v[2][8];
#pragma unroll
                for (int bj = 0; bj < 2; ++bj)
#pragma unroll
                    for (int n = 0; n < 2; ++n)
#pragma unroll
                        for (int e = 0; e < 4; ++e) v[bj][4 * n + e] = acc[ai][bj][m][n][e];
                if (type == 1) {
                    float ss = 0.f;
#pragma unroll
                    for (int bj = 0; bj < 2; ++bj)
#pragma unroll
                        for (int i = 0; i < 8; ++i) ss += v[bj][i] * v[bj][i];
                    ss = sum_fq(ss);
                    const float rinv = __builtin_amdgcn_rsqf(ss * (1.0f / 64.0f) + EPS);
#pragma unroll
                    for (int bj = 0; bj < 2; ++bj)
#pragma unroll
                        for (int i = 0; i < 8; ++i) v[bj][i] = v[bj][i] * rinv * w[bj][i];
                    if (rope_on) {
                        const int t = (pm & 15) * 256 + rr;
                        const int pos = (fq >> 1) ? (t & 63) : (t >> 6);
                        const GAS float* tb = rope + (size_t)(pos * 16 + 8 * (fq & 1)) * 2;
#pragma unroll
                        for (int q4 = 0; q4 < 4; ++q4) { const f32x4 cs = *(const GAS f32x4*)(tb + 4 * q4);
                            { const int i = 2 * q4; const float x1 = v[0][i], x2 = v[1][i]; v[0][i] = x1 * cs[0] - x2 * cs[1]; v[1][i] = x2 * cs[0] + x1 * cs[1]; }
                            { const int i = 2 * q4 + 1; const float x1 = v[0][i], x2 = v[1][i]; v[0][i] = x1 * cs[2] - x2 * cs[3]; v[1][i] = x2 * cs[2] + x1 * cs[3]; } }
                    }
                } else if (type == 2) {
#pragma unroll
                    for (int bj = 0; bj < 2; ++bj)
#pragma unroll
                        for (int i = 0; i < 8; ++i) v[bj][i] = v[bj][i] * fsigmoid(v[bj][i]);
                } else if (type == 3) {
#pragma unroll
                    for (int i = 0; i < 8; ++i) { const float da = 1.0f + __builtin_amdgcn_exp2f(-v[0][i] * LOG2E), db = 1.0f + __builtin_amdgcn_exp2f(fminf(-v[1][i] * LOG2E, 80.0f));
                        v[0][i] = db * __builtin_amdgcn_rcpf(da); v[1][i] = __builtin_amdgcn_rcpf(db); }
                }
                GAS bf16_t* rowp = dst + (size_t)(rowbase + rr) * pitch;
#pragma unroll
                for (int bj = 0; bj < 2; ++bj) { u32x4 o; o.x = cvtpk(v[bj][0], v[bj][1]); o.y = cvtpk(v[bj][2], v[bj][3]); o.z = cvtpk(v[bj][4], v[bj][5]); o.w = cvtpk(v[bj][6], v[bj][7]);
                    if (type == 3) __builtin_nontemporal_store(o, (GAS u32x4*)(rowp + (bj ? (WS_SGB - WS_SGA) / 2 : 0) + 8 * c0));
                    else if (type == 2) __builtin_nontemporal_store(o, (GAS u32x4*)(rowp + 8 * (c0 + 2 * bj))); else *(GAS u32x4*)(rowp + 8 * (c0 + 2 * bj)) = o; }
            }
    }
};

struct MergeProj {
    static constexpr int BHALF_ROWS = 128; static constexpr bool AFTER_DRAIN = false;
    __host__ __device__ static int brow(int R) { return (R & ~31) + pg8::perm32(R & 31); }
    unsigned char* ws; int layer;
    int G, c, single;
    __device__ __forceinline__ bool next(int i, pg8::Unit& u) const {
        u.sub = i & 1;
        if (single >= 0) { if (i >= 2) return false; u.pm = 64 + single / 4; u.pn = single % 4; return true; }
        const int L = (i >> 1) * G + c; if (L >= 64 * 4) return false;
        pg8::tile_of(L, 64, 4, u.pm, u.pn); return true;
    }
    __device__ __forceinline__ const char* aptr(const pg8::Unit& u) const {
        return u.pm >= 64 ? (const char*)(ws + (u.sub ? WS_YCB : WS_YCA)) + (size_t)(u.pm - 64) * 256 * 512 * 2 : (const char*)(ws + (u.sub ? WS_YB : WS_YA)) + (size_t)u.pm * 256 * 512 * 2; }
    __device__ __forceinline__ const char* bptr(const pg8::Unit& u) const { return (const char*)(ws + (u.sub ? WS_WOB : WS_WOA)) + ((size_t)layer * DM + (size_t)u.pn * 256) * 512 * 2; }
    __device__ __forceinline__ bool keep(const pg8::Unit& u) const { return u.sub == 0; }
    __device__ __forceinline__ size_t bhalf(const pg8::Unit&) const { return BHALF_ROWS; }
    __device__ __forceinline__ void a_ready(const pg8::Unit&) const {}
    __device__ __forceinline__ void epi(f32x4 (&acc)[2][2][4][2], const pg8::Unit& u, int wr, int wc, int fr, int fq) const {
        const int row0 = u.pm * 256 + wr * 64 + fr, col0 = u.pn * 256 + wc * 32 + 8 * fq;
        gptr wl = launder(ws);
        const GAS bf16_t* SGA = (const GAS bf16_t*)(wl + WS_SGA); const GAS bf16_t* SGB = (const GAS bf16_t*)(wl + WS_SGB); GAS bf16_t* MG = (GAS bf16_t*)(wl + WS_MG);
#pragma unroll
        for (int ai = 0; ai < 2; ++ai) {
            const GAS bf16_t* SG = u.sub == 0 ? SGA : SGB;
            u32x4 sv[4][2];
#pragma unroll
            for (int m = 0; m < 4; ++m)
#pragma unroll
                for (int bj = 0; bj < 2; ++bj) sv[m][bj] = *(const GAS u32x4*)(SG + (size_t)(row0 + ai * 128 + m * 16) * DM + col0 + bj * 128);
#pragma unroll
            for (int m = 0; m < 4; ++m) {
                const size_t off = (size_t)(row0 + ai * 128 + m * 16) * DM + col0;
#pragma unroll
                for (int bj = 0; bj < 2; ++bj) {
                    const u32x4 sb = sv[m][bj];
                    const float b[8] = {bflo(sb.x), bfhi(sb.x), bflo(sb.y), bfhi(sb.y), bflo(sb.z), bfhi(sb.z), bflo(sb.w), bfhi(sb.w)};
                    if (u.sub == 0) {
#pragma unroll
                        for (int n = 0; n < 2; ++n)
#pragma unroll
                            for (int e = 0; e < 4; ++e) acc[ai][bj][m][n][e] *= b[4 * n + e];
                    } else {
                        float o[8];
#pragma unroll
                        for (int n = 0; n < 2; ++n)
#pragma unroll
                            for (int e = 0; e < 4; ++e) o[4 * n + e] = acc[ai][bj][m][n][e] * b[4 * n + e];
                        u32x4 w; w.x = cvtpk(o[0], o[1]); w.y = cvtpk(o[2], o[3]); w.z = cvtpk(o[4], o[5]); w.w = cvtpk(o[6], o[7]);
                        if (u.pm >= 64) *(GAS u32x4*)((GAS bf16_t*)(wl + WS_MGC) + off - (size_t)ML * DM + bj * 128) = w;
                        else *(GAS u32x4*)(MG + off + bj * 128) = w;
                    }
                }
            }
            asm volatile("" ::: "memory");
        }
    }
};

struct OutProj {
    static constexpr int BHALF_ROWS = 128; static constexpr bool AFTER_DRAIN = true;
    __host__ __device__ static int brow(int R) { return R; }
    unsigned char* ws; int layer; const GAS float* xin; GAS float* xout; const GAS float* cin;
    int G, c, single, fuse;
    const GAS float* ng;
    __device__ __forceinline__ bool next(int i, pg8::Unit& u) const {
        u.sub = 0;
        if (single >= 0) { if (i != 0) return false; u.pm = 64 + single / 4; u.pn = single % 4; return true; }
        const int L = i * G + c; if (L >= 64 * 4 || i != 0) return false;
        pg8::tile_of(L, 64, 4, u.pm, u.pn); return true;
    }
    __device__ __forceinline__ const char* aptr(const pg8::Unit& u) const {
        return u.pm >= 64 ? (const char*)(ws + WS_MGC) + (size_t)(u.pm - 64) * 256 * DM * 2 : (const char*)(ws + WS_MG) + (size_t)u.pm * 256 * DM * 2; }
    __device__ __forceinline__ const char* bptr(const pg8::Unit& u) const { return (const char*)(ws + WS_WOUT) + ((size_t)layer * DM + (size_t)u.pn * 256) * DM * 2; }
    __device__ __forceinline__ void a_ready(const pg8::Unit&) const {}
    __device__ __forceinline__ bool keep(const pg8::Unit&) const { return false; }
    __device__ __forceinline__ size_t bhalf(const pg8::Unit&) const { return BHALF_ROWS; }
    __device__ __forceinline__ void epi_drain(f32x4 (&acc)[2][2][4][2], const pg8::Unit& u, int wr, int wc, int fr, int fq, LAS unsigned char* lds, int wid, int lane) const {
        const bool ctxrow = u.pm >= 64;
        gptr wl = launder(ws);
        GAS float* cout = (GAS float*)(wl + WS_CTXN); const GAS float* mod = (const GAS float*)(wl + WS_MOD) + (size_t)layer * 5 * 3072;
        const GAS float* src = ctxrow ? cin + (size_t)(u.pm - 64) * 256 * DM : xin + (size_t)u.pm * 256 * DM;
        GAS float* dstp = ctxrow ? cout + (size_t)(u.pm - 64) * 256 * DM : xout + (size_t)u.pm * 256 * DM;
        const GAS float* gate = mod + (ctxrow ? 4 : (u.pm >> 4)) * 3072 + 2048;
        const int col0 = u.pn * 256 + wc * 32 + 4 * fq;
        {
            f32x4 gv[2][2];
#pragma unroll
            for (int bj = 0; bj < 2; ++bj)
#pragma unroll
                for (int n = 0; n < 2; ++n) gv[bj][n] = *(const GAS f32x4*)(gate + col0 + bj * 128 + n * 16);
#pragma unroll
            for (int ai = 0; ai < 2; ++ai) {
                f32x4 xs[4][2][2];
#pragma unroll
                for (int m = 0; m < 4; ++m) { const size_t off = (size_t)(ai * 128 + wr * 64 + m * 16 + fr) * DM + col0;
#pragma unroll
                    for (int bj = 0; bj < 2; ++bj)
#pragma unroll
                        for (int n = 0; n < 2; ++n) xs[m][bj][n] = *(const GAS f32x4*)(src + off + bj * 128 + n * 16); }
#pragma unroll
                for (int m = 0; m < 4; ++m) { const size_t off = (size_t)(ai * 128 + wr * 64 + m * 16 + fr) * DM + col0;
#pragma unroll
                    for (int bj = 0; bj < 2; ++bj)
#pragma unroll
                        for (int n = 0; n < 2; ++n) { acc[ai][bj][m][n] = xs[m][bj][n] + gv[bj][n] * acc[ai][bj][m][n];
                            __builtin_nontemporal_store(acc[ai][bj][m][n], (GAS f32x4*)(dstp + off + bj * 128 + n * 16)); } }
                asm volatile("" ::: "memory");
            }
        }
        if (!fuse) return;
        const GAS float* md = (const GAS float*)(wl + WS_MOD) + (size_t)((layer + 1) * 5 + (u.pm >> 4)) * 3072;
        f32x4 gs[2][2], sh[2][2];
#pragma unroll
        for (int bj = 0; bj < 2; ++bj)
#pragma unroll
            for (int n = 0; n < 2; ++n) { const int cc = col0 + bj * 128 + n * 16;
                gs[bj][n] = *(const GAS f32x4*)(ng + cc) * (*(const GAS f32x4*)(md + 1024 + cc) + 1.0f); sh[bj][n] = *(const GAS f32x4*)(md + cc); }
        LAS float* Pp = (LAS float*)lds;
        LAS float* Sr = (LAS float*)(lds + 4096);
#pragma unroll
        for (int ai = 0; ai < 2; ++ai)
#pragma unroll
            for (int m = 0; m < 4; ++m) { float sq = 0.f;
#pragma unroll
                for (int bj = 0; bj < 2; ++bj)
#pragma unroll
                    for (int n = 0; n < 2; ++n) { const f32x4 x = acc[ai][bj][m][n]; sq += (x[0] * x[0] + x[1] * x[1]) + (x[2] * x[2] + x[3] * x[3]); }
                sq = sum_fq(sq);
                if (fq == 0) Pp[(ai * 128 + wr * 64 + m * 16 + fr) * 4 + wc] = sq; }
        asm volatile("s_waitcnt lgkmcnt(0)" ::: "memory"); __builtin_amdgcn_s_barrier(); asm volatile("" ::: "memory");
        const int row = wid * 32 + (lane & 31);
        GAS float* xb = (GAS float*)(wl + WS_XB) + ((size_t)u.pm * 256 + row) * 4;
        unsigned* pc = (unsigned*)(ws + WS_CTL) + CW_CNT + 64 * (16 + u.pm);
        if (lane < 32) { const float t4 = (Pp[row * 4 + 0] + Pp[row * 4 + 1]) + (Pp[row * 4 + 2] + Pp[row * 4 + 3]);
            __hip_atomic_store(xb + u.pn, t4, __ATOMIC_RELAXED, __HIP_MEMORY_SCOPE_AGENT); }
        asm volatile("s_waitcnt vmcnt(0)" ::: "memory");
        if (lane == 0) __hip_atomic_fetch_add(pc, 1u, __ATOMIC_RELAXED, __HIP_MEMORY_SCOPE_AGENT);
        if (wid == 0) { unsigned sp = 0;
            while ((unsigned)__builtin_amdgcn_readfirstlane(__hip_atomic_load(pc, __ATOMIC_RELAXED, __HIP_MEMORY_SCOPE_AGENT)) < 32u) { __builtin_amdgcn_s_sleep(2); if (++sp > (1u << 22)) break; }
            __builtin_amdgcn_fence(__ATOMIC_ACQUIRE, "agent"); }
        asm volatile("s_waitcnt vmcnt(0) lgkmcnt(0)" ::: "memory"); __builtin_amdgcn_s_barrier(); asm volatile("" ::: "memory");
        if (lane < 32) { float tot = 0.f;
#pragma unroll
            for (int t = 0; t < 4; ++t) tot += __hip_atomic_load(xb + t, __ATOMIC_RELAXED, __HIP_MEMORY_SCOPE_AGENT);
            Sr[row] = __builtin_amdgcn_rsqf(tot * (1.0f / DM) + EPS); }
        asm volatile("s_waitcnt vmcnt(0) lgkmcnt(0)" ::: "memory"); __builtin_amdgcn_s_barrier(); asm volatile("" ::: "memory");
        GAS bf16_t* HX = (GAS bf16_t*)(wl + WS_HX) + (size_t)u.pm * 256 * DM;
#pragma unroll
        for (int ai = 0; ai < 2; ++ai)
#pragma unroll
            for (int m = 0; m < 4; ++m) { const int rr = ai * 128 + wr * 64 + m * 16 + fr; const float r = Sr[rr];
#pragma unroll
                for (int bj = 0; bj < 2; ++bj)
#pragma unroll
                    for (int n = 0; n < 2; ++n) { const f32x4 y = acc[ai][bj][m][n] * r * gs[bj][n] + sh[bj][n];
                        *(GAS unsigned long long*)(HX + (size_t)rr * DM + col0 + bj * 128 + n * 16) = (unsigned long long)cvtpk(y[0], y[1]) | ((unsigned long long)cvtpk(y[2], y[3]) << 32); } }
    }
};

namespace attn_body {
constexpr int NW = 8, QBLK = 32, KVBLK = 64;
__device__ __forceinline__ int crow(int r, int hi) { return (r & 3) + 8 * (r >> 2) + 4 * hi; }
#define SBAR() __builtin_amdgcn_sched_barrier(0)
constexpr int NSLOT = 3, SLOTB = 8192;
constexpr int LDS_K = 0, LDS_V = NSLOT * SLOTB, LDS_WS = 2 * NSLOT * SLOTB, LDS_OST = LDS_WS + NW * 64 * 4, LDS_TAB = LDS_OST + NW * 4096, LDS_BYTES_A = LDS_TAB + 4096;
constexpr int TABM = 64, ZOFF = 640;
__device__ __forceinline__ void glds16(const GAS void* gsrc, unsigned lds_dst) { unsigned keep;
    asm volatile("s_mov_b32 %0, m0\n\ts_mov_b32 m0, %2\n\ts_nop 0\n\tglobal_load_lds_dwordx4 %1, off\n\ts_mov_b32 m0, %0" : "=&s"(keep) : "v"(gsrc), "s"(lds_dst) : "memory"); }
__device__ __forceinline__ float max3f(float a, float b, float c) { float r; asm("v_max3_f32 %0, %1, %2, %3" : "=v"(r) : "v"(a), "v"(b), "v"(c)); return r; }
__device__ __forceinline__ float max2f(float a, float b) { float r; asm("v_max_f32_e32 %0, %1, %2" : "=v"(r) : "v"(a), "v"(b)); return r; }
__device__ __forceinline__ float fadd_s(float a, float b) { float r; asm("v_add_f32_e32 %0, %1, %2" : "=v"(r) : "v"(a), "v"(b)); return r; }
__device__ __forceinline__ float fsub_s(float a, float b) { float r; asm("v_sub_f32_e32 %0, %1, %2" : "=v"(r) : "v"(a), "v"(b)); return r; }
#define WAIT_BAR(N) asm volatile("s_waitcnt vmcnt(" #N ") lgkmcnt(0)\n\ts_barrier" ::: "memory")

__device__ __forceinline__ void qkt(f32x16& p0, f32x16& p1, const char* Kslot, const bf16x8* qr, const f32x16& negm, int r32, int hi) {
    const char* kb = Kslot + hi * 1024 + r32 * 16;
#pragma unroll
    for (int d0 = 0; d0 < 4; ++d0) {
        const bf16x8 b0 = *reinterpret_cast<const bf16x8*>(kb + d0 * 2048);
        const bf16x8 b1 = *reinterpret_cast<const bf16x8*>(kb + d0 * 2048 + 512);
        if (d0 == 0) { p0 = __builtin_amdgcn_mfma_f32_32x32x16_bf16(b0, qr[0], negm, 0, 0, 0); p1 = __builtin_amdgcn_mfma_f32_32x32x16_bf16(b1, qr[0], negm, 0, 0, 0); }
        else { p0 = __builtin_amdgcn_mfma_f32_32x32x16_bf16(b0, qr[d0], p0, 0, 0, 0); p1 = __builtin_amdgcn_mfma_f32_32x32x16_bf16(b1, qr[d0], p1, 0, 0, 0); } }
}
typedef LAS const char* lds_cptr;
typedef short v4i16_t __attribute__((ext_vector_type(4)));
__device__ __forceinline__ void kload8(bf16x8* kf, lds_cptr kp) {
    kf[0] = *(const LAS bf16x8*)(kp);        kf[1] = *(const LAS bf16x8*)(kp + 512);
    kf[2] = *(const LAS bf16x8*)(kp + 2048); kf[3] = *(const LAS bf16x8*)(kp + 2560);
    kf[4] = *(const LAS bf16x8*)(kp + 4096); kf[5] = *(const LAS bf16x8*)(kp + 4608);
    kf[6] = *(const LAS bf16x8*)(kp + 6144); kf[7] = *(const LAS bf16x8*)(kp + 6656);
}
__device__ __forceinline__ void kload2(bf16x8* kf, lds_cptr kp, int j) { kf[2 * j] = *(const LAS bf16x8*)(kp + j * 2048); kf[2 * j + 1] = *(const LAS bf16x8*)(kp + j * 2048 + 512); }
__device__ __forceinline__ s16x4 vtr(lds_cptr p) { return __builtin_bit_cast(s16x4, __builtin_amdgcn_ds_read_tr16_b64_v4i16((LAS v4i16_t*)p)); }
__device__ __forceinline__ float rowmax(const f32x16& p0, const f32x16& p1) {
    float a = max3f(p0[0], p0[1], p1[0]), b = max3f(p0[2], p0[3], p1[1]); a = max3f(a, p1[2], p1[3]);
#pragma unroll
    for (int r = 4; r < 16; r += 4) { a = max3f(a, p0[r], p0[r + 1]); b = max3f(b, p0[r + 2], p0[r + 3]); a = max3f(a, p1[r], p1[r + 1]); b = max3f(b, p1[r + 2], p1[r + 3]); }
    const float m = max2f(a, b);
    auto rr = __builtin_amdgcn_permlane32_swap(__float_as_uint(m), __float_as_uint(m), false, false);
    return max2f(__uint_as_float(rr[0]), __uint_as_float(rr[1]));
}
__device__ __forceinline__ void pv(f32x16* o, int vb, bf16x8 pa0, bf16x8 pa1, bf16x8 pa2, bf16x8 pa3) {
#pragma unroll
    for (int d0 = 0; d0 < 2; ++d0) { s16x4 lo[4], hi[4];
#pragma unroll
        for (int ks = 0; ks < 4; ++ks) {
            asm volatile("ds_read_b64_tr_b16 %0,%1 offset:%c2" : "=&v"(lo[ks]) : "v"(vb), "i"(d0 * 4096 + ks * 1024) : "memory");
            asm volatile("ds_read_b64_tr_b16 %0,%1 offset:%c2" : "=&v"(hi[ks]) : "v"(vb), "i"(d0 * 4096 + ks * 1024 + 512) : "memory"); }
        asm volatile("s_waitcnt lgkmcnt(0)" ::: "memory"); SBAR();
#define PK(k) (bf16x8){lo[k][0], lo[k][1], lo[k][2], lo[k][3], hi[k][0], hi[k][1], hi[k][2], hi[k][3]}
        o[d0] = __builtin_amdgcn_mfma_f32_32x32x16_bf16(pa0, PK(0), o[d0], 0, 0, 0);
        o[d0] = __builtin_amdgcn_mfma_f32_32x32x16_bf16(pa1, PK(1), o[d0], 0, 0, 0);
        o[d0] = __builtin_amdgcn_mfma_f32_32x32x16_bf16(pa2, PK(2), o[d0], 0, 0, 0);
        o[d0] = __builtin_amdgcn_mfma_f32_32x32x16_bf16(pa3, PK(3), o[d0], 0, 0, 0);
#undef PK
    }
}

template <int MODE, int KP>
__device__ __forceinline__ void attn_unit(const GAS bf16_t* Qw0, const GAS bf16_t* Kh, const GAS bf16_t* Vh, const int NT, const int lo,
                                          GAS bf16_t* Ow0, const GAS bf16_t* Zw0, const int qr0, const GAS float* rpbh, char* shm) {
    int tid_ = threadIdx.x; asm volatile("" : "+v"(tid_));
    const int tid = tid_, lane = tid & 63, r32 = lane & 31, hi = lane >> 5; const int wid = __builtin_amdgcn_readfirstlane(tid >> 6);
    const GAS bf16_t* Qw = Qw0 + (long)(wid * QBLK) * QP;
    const unsigned lds0 = (unsigned)(uintptr_t)shm;
    float* wsf = (float*)(shm + LDS_WS) + wid * 64;
    const GAS bf16_t* ksrc = Kh + (long)lane * KP + wid * 8;
    const GAS bf16_t* vsrc = Vh + (long)(16 * (wid & 3) + (lane >> 2)) * KP + (wid >> 2) * 32 + (lane & 3) * 8;
    const unsigned kdst = lds0 + LDS_K + wid * 1024, vdst = lds0 + LDS_V + wid * 1024;
#define TMAP(t) ((MODE == 1 && (t) >= 4) ? (t) + lo : (t))
#define DMA_K(t, slot) glds16(ksrc + (long)TMAP(t) * KVBLK * KP, (unsigned)__builtin_amdgcn_readfirstlane(kdst + (slot)))
#define DMA_V(t, slot) glds16(vsrc + (long)TMAP(t) * KVBLK * KP, (unsigned)__builtin_amdgcn_readfirstlane(vdst + (slot)))
    const int vb0 = (int)(lds0 + LDS_V) + ((lane >> 4) & 1) * 32 + (lane & 3) * 8 + (4 * hi + ((lane & 15) >> 2)) * 64;
    const char* Kbase = shm + LDS_K; bf16x8 kf[8];
    const lds_cptr shm3 = (lds_cptr)shm; const lds_cptr kp0 = shm3 + LDS_K + hi * 1024 + r32 * 16; const lds_cptr vp0 = shm3 + LDS_V + ((lane >> 4) & 1) * 32 + (lane & 3) * 8 + (4 * hi + ((lane & 15) >> 2)) * 64;
    DMA_K(0, 0); DMA_V(0, 0); DMA_K(1, SLOTB);
    bf16x8 qr[4];
#pragma unroll
    for (int d0 = 0; d0 < 4; ++d0) qr[d0] = *(const GAS bf16x8*)(Qw + (long)r32 * QP + d0 * 16 + hi * 8);
    int na_qr = 0, na_rs = 0; const LAS float* na_tb = nullptr; const LAS float* na_tm = nullptr;
    if (MODE == 1) {
        LAS float* tab = (LAS float*)(shm3 + LDS_TAB);
        for (int i = tid; i < ZOFF + 128; i += NW * 64) { float v = 0.f;
            if (i >= ZOFF) v = (i - ZOFF >= 48 && i - ZOFF < 64) ? 0.f : -INFINITY;
            else if (i >= TABM && i < TABM + 15 * 32) { const int dr = (i - TABM) >> 5, dc = (i - TABM) & 31; if (dc < 31) v = rpbh[dr * 31 + dc] * LOG2E; }
            tab[i] = v; }
        na_qr = qr0 + (wid >> 1);
        na_rs = na_qr - 4; na_rs = na_rs < 0 ? 0 : (na_rs > 56 ? 56 : na_rs);
        const int qc = 32 * (wid & 1) + r32; int cs = qc - 8; cs = cs < 0 ? 0 : (cs > 48 ? 48 : cs);
        na_tb = (const LAS float*)(shm3 + LDS_TAB) + TABM + (4 * hi - qc + 15);
        na_tm = (const LAS float*)(shm3 + LDS_TAB) + ZOFF + (4 * hi - cs + 48);
    }
    float l_reg = 0.f; f32x16 o[2]; o[0] = f32x16{}; o[1] = f32x16{}; const f32x16 zc = f32x16{};
#define CMASK(P0, P1, t) do { if (MODE == 1 && (t) >= 4) { const float NEG_ = -INFINITY; const int kr_ = lo + (t) - 4; \
        if ((unsigned)(kr_ - na_rs) < 8u) { const LAS float* tb_ = na_tb + (kr_ - na_qr + 7) * 32; const LAS float* tm_ = na_tm; asm volatile("" : "+v"(tm_)); \
            _Pragma("unroll") for (int g_ = 0; g_ < 4; ++g_) { \
              _Pragma("unroll") for (int r = 4 * g_; r < 4 * g_ + 4; ++r) { const int kc_ = (r & 3) + 8 * (r >> 2); \
                P0[r] += tb_[kc_] + tm_[kc_]; P1[r] += tb_[kc_ + 32] + tm_[kc_ + 32]; } \
              asm volatile("" : "+v"(P0), "+v"(P1)); SBAR(); } } \
        else { _Pragma("unroll") for (int r = 0; r < 16; ++r) { P0[r] = NEG_; P1[r] = NEG_; } } } } while (0)
    f32x16 pA0, pA1, pB0, pB1;
    int sl_prev = 0, sl_cur = 0, sl_next = SLOTB;
#define ROT() do { sl_prev = sl_cur; sl_cur = sl_next; sl_next = (sl_next == (NSLOT - 1) * SLOTB) ? 0 : sl_next + SLOTB; } while (0)
    DMA_K(2, 2 * SLOTB);
    WAIT_BAR(3);
    qkt(pA0, pA1, Kbase, qr, zc, r32, hi); asm volatile("s_nop 15\n\ts_nop 7" : "+v"(pA0), "+v"(pA1));
    _Pragma("unroll") for (int r = 0; r < 16; ++r) pA0[r] = __builtin_amdgcn_exp2f(pA0[r]);
    _Pragma("unroll") for (int r = 0; r < 16; ++r) pA1[r] = __builtin_amdgcn_exp2f(pA1[r]);
    WAIT_BAR(0);
    DMA_K(3, 0); DMA_V(1, SLOTB);
    ROT();
    kload8(kf, kp0 + sl_cur);
    WAIT_BAR(2);
    s16x4 vlo[8], vhi[8]; u32x4 pw0, pw1, pw2, pw3;
#define PKW(P, B) cvtpk(P[B], P[B + 1])
#define PAF(k) __builtin_bit_cast(bf16x8, pw##k)
#define VFR(i) (bf16x8){vlo[i][0], vlo[i][1], vlo[i][2], vlo[i][3], vhi[i][0], vhi[i][1], vhi[i][2], vhi[i][3]}
#define PIN(x) asm volatile("" : "+v"(x))
#define GAPA(MF, A0, A1, A2, A3, W0, W1, PW) do { __builtin_amdgcn_s_setprio(1); MF; __builtin_amdgcn_s_setprio(0); sacc += A0; sacc += A1; sacc += A2; sacc += A3; PIN(sacc); W0; W1; PIN(PW); SBAR(); } while (0)
#define EX(v) __builtin_amdgcn_exp2f(v)
#define GAPB(MF, X, B) do { __builtin_amdgcn_s_setprio(1); MF; __builtin_amdgcn_s_setprio(0); X[B] = EX(X[B]); X[B + 1] = EX(X[B + 1]); X[B + 2] = EX(X[B + 2]); X[B + 3] = EX(X[B + 3]); PIN(X); SBAR(); } while (0)
#define VRD(i) do { vlo[i] = vtr(vp_ + (((i) >> 2) * 4096 + ((i) & 3) * 1024)); vhi[i] = vtr(vp_ + (((i) >> 2) * 4096 + ((i) & 3) * 1024 + 512)); } while (0)
#define KRD(G, j) do { if (G) { kload2(kf, kp0 + sl_next, j); SBAR(); } } while (0)
#define STEP(C0, C1, P0, P1, t, GK, GV, GL) do { SBAR(); \
    const lds_cptr vp_ = vp0 + sl_prev; \
    VRD(0); SBAR(); float sacc = (P0[0] + P0[1]); \
    GAPA(C0 = __builtin_amdgcn_mfma_f32_32x32x16_bf16(kf[0], qr[0], zc, 0, 0, 0), P0[2], P0[3], P0[4], P0[5],     pw0[0] = PKW(P0, 0), pw0[1] = PKW(P0, 2), pw0); \
    VRD(4); SBAR(); GAPA(C1 = __builtin_amdgcn_mfma_f32_32x32x16_bf16(kf[1], qr[0], zc, 0, 0, 0), P0[6], P0[7], P0[8], P0[9],     pw0[2] = PKW(P0, 4), pw0[3] = PKW(P0, 6), pw0); \
    VRD(1); SBAR(); GAPA(C0 = __builtin_amdgcn_mfma_f32_32x32x16_bf16(kf[2], qr[1], C0, 0, 0, 0),   P0[10], P0[11], P0[12], P0[13], pw1[0] = PKW(P0, 8), pw1[1] = PKW(P0, 10), pw1); \
    VRD(5); SBAR(); GAPA(C1 = __builtin_amdgcn_mfma_f32_32x32x16_bf16(kf[3], qr[1], C1, 0, 0, 0),   P0[14], P0[15], P1[0], P1[1],   pw1[2] = PKW(P0, 12), pw1[3] = PKW(P0, 14), pw1); \
    VRD(2); SBAR(); GAPA(C0 = __builtin_amdgcn_mfma_f32_32x32x16_bf16(kf[4], qr[2], C0, 0, 0, 0),   P1[2], P1[3], P1[4], P1[5],     pw2[0] = PKW(P1, 0), pw2[1] = PKW(P1, 2), pw2); \
    VRD(6); SBAR(); GAPA(C1 = __builtin_amdgcn_mfma_f32_32x32x16_bf16(kf[5], qr[2], C1, 0, 0, 0),   P1[6], P1[7], P1[8], P1[9],     pw2[2] = PKW(P1, 4), pw2[3] = PKW(P1, 6), pw2); \
    VRD(3); SBAR(); GAPA(C0 = __builtin_amdgcn_mfma_f32_32x32x16_bf16(kf[6], qr[3], C0, 0, 0, 0),   P1[10], P1[11], P1[12], P1[13], pw3[0] = PKW(P1, 8), pw3[1] = PKW(P1, 10), pw3); \
    VRD(7); SBAR(); GAPA(C1 = __builtin_amdgcn_mfma_f32_32x32x16_bf16(kf[7], qr[3], C1, 0, 0, 0),   P1[14], P1[15], 0.f, 0.f,       pw3[2] = PKW(P1, 12), pw3[3] = PKW(P1, 14), pw3); \
    l_reg += sacc; \
    if (GK) { DMA_K((t) + 3, sl_cur); } if (GV) { DMA_V((t) + 1, sl_next); } \
    CMASK(C0, C1, t); \
    SBAR(); \
    GAPB(o[0] = __builtin_amdgcn_mfma_f32_32x32x16_bf16(PAF(0), VFR(0), o[0], 0, 0, 0), C0, 0); \
    GAPB(o[1] = __builtin_amdgcn_mfma_f32_32x32x16_bf16(PAF(0), VFR(4), o[1], 0, 0, 0), C0, 4); \
    KRD(GL, 0); GAPB(o[0] = __builtin_amdgcn_mfma_f32_32x32x16_bf16(PAF(1), VFR(1), o[0], 0, 0, 0), C0, 8); \
    KRD(GL, 1); GAPB(o[1] = __builtin_amdgcn_mfma_f32_32x32x16_bf16(PAF(1), VFR(5), o[1], 0, 0, 0), C0, 12); \
    KRD(GL, 2); GAPB(o[0] = __builtin_amdgcn_mfma_f32_32x32x16_bf16(PAF(2), VFR(2), o[0], 0, 0, 0), C1, 0); \
    KRD(GL, 3); GAPB(o[1] = __builtin_amdgcn_mfma_f32_32x32x16_bf16(PAF(2), VFR(6), o[1], 0, 0, 0), C1, 4); \
    GAPB(o[0] = __builtin_amdgcn_mfma_f32_32x32x16_bf16(PAF(3), VFR(3), o[0], 0, 0, 0), C1, 8); \
    GAPB(o[1] = __builtin_amdgcn_mfma_f32_32x32x16_bf16(PAF(3), VFR(7), o[1], 0, 0, 0), C1, 12); \
    } while (0)
    int t = 1;
    for (; t + 5 < NT; t += 2) {
        STEP(pB0, pB1, pA0, pA1, t, true, true, true);     WAIT_BAR(2); ROT();
        STEP(pA0, pA1, pB0, pB1, t + 1, true, true, true); WAIT_BAR(2); ROT();
    }
#define ENDW(tt) do { if ((tt) + 3 < NT) { WAIT_BAR(2); } else if ((tt) + 2 < NT) { WAIT_BAR(1); } else { WAIT_BAR(0); } } while (0)
    for (; t + 1 < NT; t += 2) {
        STEP(pB0, pB1, pA0, pA1, t, (t + 3 < NT), (t + 1 < NT), (t + 1 < NT));         ENDW(t);     ROT();
        STEP(pA0, pA1, pB0, pB1, t + 1, (t + 4 < NT), (t + 2 < NT), (t + 2 < NT));     ENDW(t + 1); ROT();
    }
#define DRAIN(PX0, PX1, SLOT) do { float sacc = PX0[0] + PX0[1]; _Pragma("unroll") for (int r = 2; r < 16; ++r) sacc += PX0[r]; _Pragma("unroll") for (int r = 0; r < 16; ++r) sacc += PX1[r]; l_reg += sacc; \
      pw0 = (u32x4){PKW(PX0, 0), PKW(PX0, 2), PKW(PX0, 4), PKW(PX0, 6)}; pw1 = (u32x4){PKW(PX0, 8), PKW(PX0, 10), PKW(PX0, 12), PKW(PX0, 14)}; pw2 = (u32x4){PKW(PX1, 0), PKW(PX1, 2), PKW(PX1, 4), PKW(PX1, 6)}; pw3 = (u32x4){PKW(PX1, 8), PKW(PX1, 10), PKW(PX1, 12), PKW(PX1, 14)}; \
      SBAR(); pv(o, vb0 + (SLOT), PAF(0), PAF(1), PAF(2), PAF(3)); } while (0)
    if (t < NT) { STEP(pB0, pB1, pA0, pA1, NT - 1, false, false, false); DRAIN(pB0, pB1, sl_cur); }
    else { DRAIN(pA0, pA1, sl_prev); }
#undef DRAIN
#undef PKW
#undef PAF
#undef VFR
#undef PIN
#undef GAPA
#undef GAPB
#undef EX
#undef VRD
#undef KRD
#undef STEP
#undef ENDW
    { auto rr = __builtin_amdgcn_permlane32_swap(__float_as_uint(l_reg), __float_as_uint(l_reg), false, false); l_reg = __uint_as_float(rr[0]) + __uint_as_float(rr[1]); }
    if (hi == 0) wsf[32 + r32] = l_reg; asm volatile("s_waitcnt lgkmcnt(0)" ::: "memory");
    float rli[16];
#pragma unroll
    for (int r = 0; r < 16; ++r) rli[r] = __builtin_amdgcn_rcpf(wsf[32 + crow(r, hi)]);
    GAS bf16_t* Ow = Ow0 + (long)(wid * QBLK) * QP; const GAS bf16_t* Zw = Zw0 + (long)(wid * QBLK) * QP;
    { __hip_bfloat16* stg = (__hip_bfloat16*)(shm + LDS_OST) + wid * 2048;
#pragma unroll
      for (int r = 0; r < 16; ++r) { const int orow = crow(r, hi);
#pragma unroll
        for (int d0 = 0; d0 < 2; ++d0) stg[orow * 64 + d0 * 32 + r32] = __float2bfloat16(o[d0][r] * rli[r]); }
      asm volatile("s_waitcnt lgkmcnt(0)" ::: "memory");
#pragma unroll
      for (int i = 0; i < 4; ++i) { const int row = i * 8 + (lane >> 3), ch = lane & 7; const u32x4 v = *(const u32x4*)(stg + row * 64 + ch * 8);
        const u32x4 z = *(const GAS u32x4*)(Zw + (long)row * QP + ch * 8); u32x4 y;
        y.x = cvtpk(bflo(v.x) * bflo(z.x), bfhi(v.x) * bfhi(z.x)); y.y = cvtpk(bflo(v.y) * bflo(z.y), bfhi(v.y) * bfhi(z.y));
        y.z = cvtpk(bflo(v.z) * bflo(z.z), bfhi(v.z) * bfhi(z.z)); y.w = cvtpk(bflo(v.w) * bflo(z.w), bfhi(v.w) * bfhi(z.w));
        *(GAS u32x4*)(Ow + (long)row * QP + ch * 8) = y; } }
    asm volatile("s_waitcnt lgkmcnt(0)\n\ts_barrier" ::: "memory");
#undef DMA_K
#undef DMA_V
#undef TMAP
#undef CMASK
#undef ROT
}
#undef SBAR
#undef WAIT_BAR
}

#define XB_TMO      128
#define XB_XCNT(j)  (256  + 64 * (j))
#define XB_XSUB(j)  (1280 + 64 * (j))
#define XB_XGEN(j)  (2304 + 64 * (j))
#define XB_TOP      3328
#define XB_TOPGEN   3392
#define XCD_BAR_WORDS 3456
#define XB_SPIN_CAP (1u << 18)
__device__ __forceinline__ unsigned xb_ld(unsigned* p)              { return __hip_atomic_load(p, __ATOMIC_RELAXED, __HIP_MEMORY_SCOPE_AGENT); }
__device__ __forceinline__ unsigned xb_add(unsigned* p, unsigned v) { return __hip_atomic_fetch_add(p, v, __ATOMIC_RELAXED, __HIP_MEMORY_SCOPE_AGENT); }
__device__ __forceinline__ unsigned xb_xcc_id() { return (unsigned)__builtin_amdgcn_s_getreg((3 << 11) | 20) & 0xFu; }
#define XB_SPIN(cond, bar) do { unsigned _sp = 0; while (cond) { __builtin_amdgcn_s_sleep(1); \
    if ((++_sp & 255u) == 0u) { if (xb_ld(&(bar)[XB_TMO])) break; if (_sp > XB_SPIN_CAP) { atomicAdd(&(bar)[XB_TMO], 1u); break; } } } } while (0)
struct XcdBarrier { unsigned* bar; unsigned x; volatile LAS unsigned* st; };
__device__ __forceinline__ XcdBarrier xcd_barrier_post(unsigned* bar, volatile LAS unsigned* st) {
    XcdBarrier b; b.bar = bar; b.x = xb_xcc_id(); b.st = st;
    if (threadIdx.x == 0) (void)xb_add(&bar[XB_XCNT(b.x)], 1u);
    return b;
}
__device__ __forceinline__ void xcd_barrier_complete(unsigned* bar, unsigned x, unsigned& nloc, unsigned& nx) {
    const unsigned G = gridDim.x * gridDim.y * gridDim.z;
    unsigned sum, cnt, mine, sp = 0u;
    for (;;) {
        sum = 0u; cnt = 0u; mine = 0u;
#pragma unroll
        for (unsigned j = 0; j < 16; ++j) { const unsigned c = xb_ld(&bar[XB_XCNT(j)]); sum += c; cnt += (c > 0u) ? 1u : 0u; mine = (j == x) ? c : mine; }
        if (sum == G) break;
        __builtin_amdgcn_s_sleep(1);
        if ((++sp & 255u) == 0u) { if (xb_ld(&bar[XB_TMO])) break; if (sp > XB_SPIN_CAP) { atomicAdd(&bar[XB_TMO], 1u); break; } }
    }
    nloc = mine > 0u ? mine : 1u; nx = cnt > 0u ? cnt : 1u;
}
__device__ __forceinline__ void xcd_barrier(const XcdBarrier& b) {
    asm volatile("s_waitcnt vmcnt(0)" ::: "memory");
    __syncthreads();
    if (threadIdx.x == 0) {
        unsigned* bar = b.bar;
        __builtin_amdgcn_s_waitcnt(0);
        unsigned nloc = b.st[0], nx = b.st[1];
        if (nloc == 0u) { xcd_barrier_complete(bar, b.x, nloc, nx); b.st[0] = nloc; b.st[1] = nx; }
        const unsigned old = xb_add(&bar[XB_XSUB(b.x)], 1u);
        const unsigned gen = old / nloc;
        if (old + 1u == (gen + 1u) * nloc) {
            __builtin_amdgcn_fence(__ATOMIC_RELEASE, "agent");
            asm volatile("s_waitcnt vmcnt(0)" ::: "memory");
            const unsigned og = xb_add(&bar[XB_TOP], 1u);
            const unsigned tg = og / nx;
            if (og + 1u == (tg + 1u) * nx) xb_add(&bar[XB_TOPGEN], 1u);
            else XB_SPIN(xb_ld(&bar[XB_TOPGEN]) == tg, bar);
            __builtin_amdgcn_fence(__ATOMIC_ACQUIRE, "agent");
            xb_add(&bar[XB_XGEN(b.x)], 1u);
            asm volatile("s_waitcnt vmcnt(0)" ::: "memory");
        } else {
            XB_SPIN(xb_ld(&bar[XB_XGEN(b.x)]) == gen, bar);
            __builtin_amdgcn_fence(__ATOMIC_ACQUIRE, "agent");
            asm volatile("s_waitcnt vmcnt(0)" ::: "memory");
        }
    }
    __syncthreads();
}

__device__ __forceinline__ float wave_sum(float v) {
#pragma unroll
    for (int o = 1; o < 64; o <<= 1) v += __shfl_xor(v, o);
    return v;
}
__device__ __forceinline__ void p0_transpose_item(const float* W, int K, int N, bf16_t* WT, LAS float* scr, int item, int lane) {
    const int nblk = N / 32, kb = item / nblk, nb = item % nblk, k0 = 64 * kb, n0 = 32 * nb;
#pragma unroll 8
    for (int i = 0; i < 32; ++i) { const int kk = 2 * i + (lane >> 5); scr[kk * 33 + (lane & 31)] = __builtin_nontemporal_load(W + (size_t)(k0 + kk) * N + n0 + (lane & 31)); }
    LDS_WAIT(); asm volatile("" ::: "memory");
    const int c = lane & 7;
#pragma unroll
    for (int j = 0; j < 4; ++j) { const int n = (lane >> 3) + 8 * j; const LAS float* s = scr + (8 * c) * 33 + n;
        u32x4 o; o.x = cvtpk(s[0 * 33], s[1 * 33]); o.y = cvtpk(s[2 * 33], s[3 * 33]); o.z = cvtpk(s[4 * 33], s[5 * 33]); o.w = cvtpk(s[6 * 33], s[7 * 33]);
        *(GAS u32x4*)(WT + (size_t)(n0 + n) * K + k0 + 8 * c) = o; }
    LDS_WAIT(); asm volatile("" ::: "memory");
}

#ifndef DUP_PHASE
#define DUP_PHASE -1
#endif
struct Args { const float* in[16]; float* out; unsigned char* ws; };

__device__ __forceinline__ void p1_rows(const GAS float* x, const GAS float* cx, const GAS float* g, const GAS float* mod, GAS bf16_t* HX, int m0, int m1, int mstep, int lane) {
    for (int m = m0; m < m1; m += mstep) {
        const bool isc = m >= ML;
        const GAS float* xrow = isc ? cx + (size_t)(m - ML) * DM : x + (size_t)m * DM;
        const GAS float* md = mod + (isc ? 4 : (m >> 12)) * 3072;
        const GAS f32x4* xr = (const GAS f32x4*)xrow + lane;
        f32x4 v[4]; float s = 0.f;
#pragma unroll
        for (int j = 0; j < 4; ++j) { v[j] = __builtin_nontemporal_load(xr + 64 * j); s += (v[j].x * v[j].x + v[j].y * v[j].y) + (v[j].z * v[j].z + v[j].w * v[j].w); }
        const float r = __builtin_amdgcn_rsqf(wave_sum(s) * (1.f / DM) + EPS);
        GAS unsigned long long* o8 = (GAS unsigned long long*)(HX + (size_t)m * DM) + lane;
#pragma unroll
        for (int j = 0; j < 4; ++j) {
            const f32x4 gg = *((const GAS f32x4*)g + lane + 64 * j), sh = *((const GAS f32x4*)md + lane + 64 * j), sc = *((const GAS f32x4*)(md + 1024) + lane + 64 * j);
            const f32x4 y = v[j] * r * gg * (sc + 1.0f) + sh;
            o8[64 * j] = (unsigned long long)cvtpk(y.x, y.y) | ((unsigned long long)cvtpk(y.z, y.w) << 32);
        }
    }
}

__global__ void __launch_bounds__(NWAVES * 64, 2) dit_fwd(Args args) {
    extern __shared__ __attribute__((aligned(16))) unsigned char lds_raw[];
    LAS unsigned char* lds = (LAS unsigned char*)lds_raw;
    volatile LAS unsigned* MISC = (volatile LAS unsigned*)(lds + MISC_OFF);
    const int tid = threadIdx.x, lane = tid & 63, wave = __builtin_amdgcn_readfirstlane(tid >> 6);
    const int G = gridDim.x; const int bx = blockIdx.x; const int vcu = (G % 8 == 0) ? (bx % 8) * (G / 8) + bx / 8 : bx;
    unsigned char* ws = args.ws;
    unsigned* ctl = (unsigned*)(ws + WS_CTL);
    for (int u = tid; u < (LDS_BYTES - LDSCTL_OFF) / 4; u += NWAVES * 64) ((LAS unsigned*)(lds + LDSCTL_OFF))[u] = 0u;
    __syncthreads();
    XcdBarrier bar = xcd_barrier_post(ctl + CW_BAR, MISC + 8);

    float* out = args.out;
    const int gw = vcu * NWAVES + wave, NGW = G * NWAVES;

    {
        const float* c_in = args.in[1]; const float* cctx = args.in[3]; const float* w_ada = args.in[4]; const float* b_ada = args.in[5];
        float* MOD = (float*)(ws + WS_MOD); float* ROPE = (float*)(ws + WS_ROPE); float* NWT = (float*)(ws + WS_NW);
        for (int task = vcu; task < 193; task += G) if (task < 192) {
            LAS float* sc = (LAS float*)lds;
            LAS float* red = (LAS float*)(lds + 20480);
            for (int i = tid; i < 5 * 1024; i += NWAVES * 64) { const float cv = (i < 4096) ? c_in[i] : cctx[i - 4096]; sc[i] = cv * fsigmoid(cv); }
            __syncthreads();
            const int l = task / 96, n0 = (task % 96) * 32, col = lane & 31, kh = lane >> 5;
            const float* wp = w_ada + (size_t)l * 1024 * 3072 + n0 + col;
            float a0 = 0.f, a1 = 0.f, a2 = 0.f, a3 = 0.f, a4 = 0.f;
            const int kbase = 128 * wave + 64 * kh;
#pragma unroll 8
            for (int i = 0; i < 64; ++i) { const int k = kbase + i; const float wv = wp[(size_t)k * 3072];
                a0 += sc[k] * wv; a1 += sc[1024 + k] * wv; a2 += sc[2048 + k] * wv; a3 += sc[3072 + k] * wv; a4 += sc[4096 + k] * wv; }
            const int slot = wave * 2 + kh;
            red[(slot * 5 + 0) * 32 + col] = a0; red[(slot * 5 + 1) * 32 + col] = a1; red[(slot * 5 + 2) * 32 + col] = a2; red[(slot * 5 + 3) * 32 + col] = a3; red[(slot * 5 + 4) * 32 + col] = a4;
            __syncthreads();
            if (tid < 160) { const int r = tid >> 5, cc = tid & 31; float sm = 0.f;
                for (int sl = 0; sl < 16; ++sl) sm += red[(sl * 5 + r) * 32 + cc];
                MOD[(size_t)(l * 5 + r) * 3072 + n0 + cc] = sm + b_ada[l * 3072 + n0 + cc]; }
            asm volatile("s_waitcnt vmcnt(0)" ::: "memory"); __syncthreads();
            if (tid == 0) { __builtin_amdgcn_fence(__ATOMIC_RELEASE, "agent"); asm volatile("s_waitcnt vmcnt(0)" ::: "memory"); (void)xb_add(ctl + CW_CNT + 64 * 12, 1u); }
        } else {
            for (int i = tid; i < 64 * 16; i += NWAVES * 64) { const int pos = i >> 4, j = i & 15;
                const float inv = 1.0f / powf(10000.0f, (float)j / 16.0f); const float ang = (float)pos * inv;
                ROPE[2 * i] = cosf(ang); ROPE[2 * i + 1] = sinf(ang); }
            if (tid < 512) { const int l = tid >> 8, w = (tid >> 6) & 3, d = tid & 63; NWT[tid] = args.in[8 + w][l * 64 + d]; }
        }
        const float* w_in = args.in[7]; const float* w_o_a = args.in[13]; const float* w_o_b = args.in[14]; const float* w_out = args.in[15];
        bf16_t* WIN = (bf16_t*)(ws + WS_WIN); bf16_t* WOA = (bf16_t*)(ws + WS_WOA); bf16_t* WOB = (bf16_t*)(ws + WS_WOB); bf16_t* WOUT = (bf16_t*)(ws + WS_WOUT);
        LAS float* scr = (LAS float*)(lds + 32768 + wave * 8704);
        constexpr int I_IN = (DM / 64) * (INC / 32), I_O = (512 / 64) * (DM / 32), I_OUT = (DM / 64) * (DM / 32), I_L = I_IN + 2 * I_O + I_OUT;
        for (int it = gw; it < 2 * I_L; it += NGW) {
            const int l = it / I_L; int r = it % I_L;
            if (r < I_IN) { p0_transpose_item(w_in + (size_t)l * DM * INC, DM, INC, WIN + (size_t)l * INC * DM, scr, r, lane); continue; } r -= I_IN;
            if (r < I_O) { p0_transpose_item(w_o_a + (size_t)l * 512 * DM, 512, DM, WOA + (size_t)l * DM * 512, scr, r, lane); continue; } r -= I_O;
            if (r < I_O) { p0_transpose_item(w_o_b + (size_t)l * 512 * DM, 512, DM, WOB + (size_t)l * DM * 512, scr, r, lane); continue; } r -= I_O;
            p0_transpose_item(w_out + (size_t)l * DM * DM, DM, DM, WOUT + (size_t)l * DM * DM, scr, r, lane);
        }
    }

    enum { K_NONE = 0, K_P1, K_INPROJ, K_ATTN, K_MERGE, K_OUT };
    unsigned* cnt = ctl + CW_CNT;
    for (int step = 0; step < 12; ++step) {
        int kind = K_NONE, layer = step >= 5 ? 1 : 0, i0 = 0, i1 = 1 << 20, single = -1, waitc = -1, sigc = -1, extraL = -1, ctx_extra = -1; unsigned need = 4u;
        int m0 = 0, m1 = 0, mstep = 1;
        bool bar_after = true;
        switch (step) {
            case 0: kind = K_P1; m0 = gw; m1 = MT; mstep = NGW; waitc = 12; need = 192u; break;
            case 1: kind = K_INPROJ; break;
            case 2: kind = K_ATTN; break;
            case 3: kind = K_MERGE; break;
            case 4: kind = K_OUT; break;
            case 5: kind = K_NONE; bar_after = false; break;
            case 6: bar_after = false;
                if (bx >= 64 && bx < 80) { kind = K_MERGE; layer = 0; single = bx - 64; sigc = (bx - 64) >> 2; }
                else { kind = K_INPROJ; if (bx >= 80 && bx < 96) i1 = 2; else if (bx >= 164 && bx < 228) i1 = 4;
                       else if (bx >= 112 && bx < 132) ctx_extra = bx - 112;
                       else if (bx >= 132 && bx < 148) extraL = 4 * G + 64 + (bx - 132);
                       else if (bx >= 148 && bx < 164) extraL = 4 * G + 80 + (bx - 148); }
                break;
            case 7: bar_after = false;
                if (bx >= 64 && bx < 80) { kind = K_INPROJ; i1 = 4; }
                else if (bx >= 80 && bx < 96) { kind = K_OUT; layer = 0; single = bx - 80; waitc = (bx - 80) >> 2; sigc = 4 + ((bx - 80) >> 2); }
                else if (bx >= 164 && bx < 228) { kind = K_P1; m0 = ML + (bx - 164) * 16 + wave; m1 = ML + (bx - 164) * 16 + 16; mstep = NWAVES; waitc = 4 + ((bx - 164) >> 4); sigc = 8 + ((bx - 164) >> 4); }
                break;
            case 8:
                if (bx >= 80 && bx < 96) { kind = K_INPROJ; i0 = 2; i1 = 4; } else if (bx >= 164 && bx < 228) { kind = K_INPROJ; i0 = 4; }
                break;
            case 9: kind = K_ATTN; break;
            case 10: kind = K_MERGE; break;
            default: kind = K_OUT; bar_after = false; break;
        }
        const bool upd = (layer == 0);
        if (waitc >= 0) {
            if (tid == 0) { unsigned sp = 0; while (xb_ld(cnt + 64 * waitc) < need) { __builtin_amdgcn_s_sleep(2); if (++sp > (1u << 22)) break; }
                __builtin_amdgcn_fence(__ATOMIC_ACQUIRE, "agent"); asm volatile("s_waitcnt vmcnt(0)" ::: "memory"); }
            __syncthreads();
        }
        switch (kind) {
        case K_P1: {
            gptr wl = launder(ws); int lane_ = threadIdx.x & 63; asm volatile("" : "+v"(lane_));
            const GAS float* xl = layer == 0 ? (const GAS float*)args.in[0] : (const GAS float*)out;
            const GAS float* cl = layer == 0 ? (const GAS float*)args.in[2] : (const GAS float*)(wl + WS_CTXN);
            p1_rows(xl, cl, (const GAS float*)args.in[6] + layer * DM, (const GAS float*)(wl + WS_MOD) + (size_t)layer * 5 * 3072, (GAS bf16_t*)(wl + WS_HX), m0, m1, mstep, lane_);
        } break;
        case K_INPROJ: {
            InProj p; p.ws = ws; p.layer = layer; p.nM = upd ? 68 : 64; p.nmain = p.nM * 21; p.G = G; p.c = bx; p.i0 = i0; p.i1 = i1; p.single = single; p.extraL = extraL; p.ctx_extra = ctx_extra; p.wcnt = cnt + 64 * (8 + (ctx_extra >= 0 ? ctx_extra / 5 : 0)); p.wneed = 16u;
            pg8::gemm_phase<InProj, DM>(lds, p);
        } break;
        case K_ATTN: {
            char* shm = (char*)lds_raw;
            for (int ug = vcu; ug < 512; ug += G) {
                const int i = ug >> 8, x8 = (ug >> 5) & 7, j = ug & 31;
                const int b = x8 >> 1, kh = x8 & 1, h = kh * 4 + (j >> 3), qb = (j & 7) * 2 + i;
                const size_t qoff = ((size_t)b * SEQ + qb * 256) * QP + h * 64; const size_t koff = (size_t)b * KVR * 128 + kh * 64;
                gptr wl = launder(ws);
                GAS bf16_t* QB = (GAS bf16_t*)(wl + WS_QB); const GAS bf16_t* KB = (const GAS bf16_t*)(wl + WS_KB); const GAS bf16_t* VB = (const GAS bf16_t*)(wl + WS_VB); const GAS bf16_t* SZB = (const GAS bf16_t*)(wl + WS_SZB);
                attn_body::attn_unit<0, 128>(QB + qoff, KB + koff, VB + koff, KVR / 64, 0, (GAS bf16_t*)(wl + WS_YB) + qoff, SZB + qoff, 0, (const GAS float*)nullptr, shm);
            }
            for (int un = vcu; un < 512; un += G) {
                const int i = un >> 8, x8 = (un >> 5) & 7, j = un & 31;
                const int bh = x8 * 4 + (j >> 3), b = bh >> 3, h = bh & 7, qb = (j & 7) * 2 + i;
                int lo = 4 * qb - 4; lo = lo < 0 ? 0 : (lo > 56 ? 56 : lo);
                int hi = 4 * qb - 1; hi = hi < 0 ? 0 : (hi > 56 ? 56 : hi); hi += 7;
                const int nrow = hi - lo + 1;
                const size_t qoff = ((size_t)b * SEQ + qb * 256) * QP + h * 64; const size_t koff = (size_t)b * KVR * 512 + h * 64;
                gptr wl = launder(ws);
                GAS bf16_t* QA = (GAS bf16_t*)(wl + WS_QA); const GAS bf16_t* KA = (const GAS bf16_t*)(wl + WS_KA); const GAS bf16_t* VA = (const GAS bf16_t*)(wl + WS_VA); const GAS bf16_t* SZA = (const GAS bf16_t*)(wl + WS_SZA);
                attn_body::attn_unit<1, 512>(QA + qoff, KA + koff, VA + koff, 4 + nrow, lo, (GAS bf16_t*)(wl + WS_YA) + qoff, SZA + qoff, 4 * qb, (const GAS float*)args.in[12] + ((size_t)layer * 8 + h) * 15 * 31, shm);
            }
            if (upd) for (int uc = vcu; uc < 256; uc += G) if ((uc & 7) == 0 || (uc & 7) == 7) {
                const int id = (uc >> 3) * 2 + ((uc & 7) == 7 ? 1 : 0), br = id >> 5, bh = id & 31, b = bh >> 3, h = bh & 7;
                const size_t qoff = ((size_t)ML + b * CTXL) * QP + h * 64, yoff = ((size_t)b * CTXL) * QP + h * 64;
                gptr wl = launder(ws);
                if (br == 0) { const size_t koff = (size_t)b * KVR * 512 + h * 64;
                    GAS bf16_t* QA = (GAS bf16_t*)(wl + WS_QA); const GAS bf16_t* KA = (const GAS bf16_t*)(wl + WS_KA); const GAS bf16_t* VA = (const GAS bf16_t*)(wl + WS_VA); const GAS bf16_t* SZA = (const GAS bf16_t*)(wl + WS_SZA);
                    attn_body::attn_unit<0, 512>(QA + qoff, KA + koff, VA + koff, 4, 0, (GAS bf16_t*)(wl + WS_YCA) + yoff, SZA + qoff, 0, (const GAS float*)nullptr, shm); }
                else { const size_t koff = (size_t)b * KVR * 128 + (h >> 2) * 64;
                    GAS bf16_t* QB = (GAS bf16_t*)(wl + WS_QB); const GAS bf16_t* KB = (const GAS bf16_t*)(wl + WS_KB); const GAS bf16_t* VB = (const GAS bf16_t*)(wl + WS_VB); const GAS bf16_t* SZB = (const GAS bf16_t*)(wl + WS_SZB);
                    attn_body::attn_unit<0, 128>(QB + qoff, KB + koff, VB + koff, 4, 0, (GAS bf16_t*)(wl + WS_YCB) + yoff, SZB + qoff, 0, (const GAS float*)nullptr, shm); }
            }
        } break;
        case K_MERGE: {
            MergeProj p; p.ws = ws; p.layer = layer; p.G = G; p.c = bx; p.single = single;
            pg8::gemm_phase<MergeProj, 512>(lds, p);
        } break;
        case K_OUT: {
            OutProj p; p.ws = ws; p.layer = layer; p.xin = layer == 0 ? (const GAS float*)args.in[0] : (const GAS float*)out; p.xout = (GAS float*)out; p.cin = (const GAS float*)args.in[2]; p.G = G; p.c = bx; p.single = single;
            p.fuse = (step == 4) ? 1 : 0; p.ng = (const GAS float*)args.in[6] + DM;
            pg8::gemm_phase<OutProj, DM>(lds, p);
        } break;
        default: break;
        }
        if (sigc >= 0) {
            asm volatile("s_waitcnt vmcnt(0)" ::: "memory"); __syncthreads();
            if (tid == 0) { __builtin_amdgcn_fence(__ATOMIC_RELEASE, "agent"); asm volatile("s_waitcnt vmcnt(0)" ::: "memory"); (void)xb_add(cnt + 64 * sigc, 1u); }
        }
        if (bar_after) xcd_barrier(bar);
    }
}

extern "C" void kernel_launch(void* const* d_in, const int* in_sizes, int n_in, void* d_out, int out_size, void* d_ws, size_t ws_size, hipStream_t stream) {
    static int grid = 0;
    if (grid == 0) {
        if (n_in != 16 || out_size != ML * DM || ws_size < WS_USED) { fprintf(stderr, "kernel_launch: unexpected problem (n_in %d out %d ws %zu)\n", n_in, out_size, ws_size); grid = -1; return; }
        int dev = 0, cus = 0, per_cu = 0;
        if (hipGetDevice(&dev) != hipSuccess || hipDeviceGetAttribute(&cus, hipDeviceAttributeMultiprocessorCount, dev) != hipSuccess) { grid = -1; return; }
        if (hipFuncSetAttribute((const void*)dit_fwd, hipFuncAttributeMaxDynamicSharedMemorySize, LDS_BYTES) != hipSuccess) { fprintf(stderr, "kernel_launch: hipFuncSetAttribute failed\n"); grid = -1; return; }
        if (hipOccupancyMaxActiveBlocksPerMultiprocessor(&per_cu, (const void*)dit_fwd, NWAVES * 64, LDS_BYTES) != hipSuccess || per_cu < 1) { fprintf(stderr, "kernel_launch: occupancy query says %d\n", per_cu); per_cu = 1; }
        (void)hipGetLastError();
        grid = cus;
        if (grid != 256) fprintf(stderr, "kernel_launch: %d CUs; the static unit maps assume 256\n", grid);
    }
    if (grid < 0) return;
    (void)hipMemsetAsync((char*)d_ws + WS_CTL, 0, CTL_ZERO_BYTES, stream);
    Args a{};
    for (int i = 0; i < 16; ++i) a.in[i] = (const float*)d_in[i];
    a.out = (float*)d_out; a.ws = (unsigned char*)d_ws;
    hipLaunchKernelGGL(dit_fwd, dim3(grid), dim3(NWAVES * 64), LDS_BYTES, stream, a);
}
```

```cpp
#include <hip/hip_runtime.h>
#include <hip/hip_bf16.h>
#include <cstdio>
#include <cstdint>
#include <cmath>

#define LAS __attribute__((address_space(3)))
#define GAS __attribute__((address_space(1)))
typedef unsigned short bf16_t;
typedef short bf16x8 __attribute__((ext_vector_type(8)));
typedef short s16x4 __attribute__((ext_vector_type(4)));
typedef float f32x4 __attribute__((ext_vector_type(4)));
typedef float f32x16 __attribute__((ext_vector_type(16)));
typedef unsigned u32x4 __attribute__((ext_vector_type(4)));
typedef float f32x2_t __attribute__((ext_vector_type(2)));
typedef __bf16 bf16x2_t __attribute__((ext_vector_type(2)));

constexpr int DM = 1024, NB = 4, SEQ = 4096, CTXL = 256, HD = 64;
constexpr int ML = NB * SEQ;
constexpr int MC = NB * CTXL;
constexpr int MT = ML + MC;
constexpr int INC = 5376;
constexpr int KVR = CTXL + SEQ;
constexpr int QP = 512;
constexpr float EPS = 1e-6f;
constexpr float LOG2E = 1.4426950408889634f;
constexpr float C2 = 0.125f * LOG2E;

constexpr size_t MiB = 1u << 20;
constexpr size_t WS_CTL = 0, CTL_ZERO_BYTES = 128 * 1024;
constexpr size_t WS_MOD = 1 * MiB;
constexpr size_t WS_ROPE = 1 * MiB + 256 * 1024;
constexpr size_t WS_NW = 1 * MiB + 512 * 1024;
constexpr size_t WS_WIN = 2 * MiB;
constexpr size_t WS_WOA = 23 * MiB;
constexpr size_t WS_WOB = 25 * MiB;
constexpr size_t WS_WOUT = 27 * MiB;
constexpr size_t WS_CTXN = 31 * MiB;
constexpr size_t WS_HX = 36 * MiB;
constexpr size_t WS_KA = 70 * MiB;
constexpr size_t WS_VA = 87 * MiB;
constexpr size_t WS_KB = 104 * MiB;
constexpr size_t WS_VB = 109 * MiB;
constexpr size_t WS_QA = 114 * MiB;
constexpr size_t WS_QB = 131 * MiB;
constexpr size_t WS_SZA = 148 * MiB;
constexpr size_t WS_SZB = 165 * MiB;
constexpr size_t WS_SGA = 182 * MiB;
constexpr size_t WS_SGB = 216 * MiB;
constexpr size_t WS_END = 250 * MiB;
constexpr size_t WS_YA = WS_HX, WS_YB = WS_HX + 17 * MiB;
constexpr size_t WS_MG = WS_QA;
constexpr size_t WS_YCA = 250 * MiB, WS_YCB = 251 * MiB;
constexpr size_t WS_MGC = 252 * MiB;
constexpr size_t WS_USED = 254 * MiB;
constexpr int CW_BAR = 4096;
constexpr size_t WS_XB = 1 * MiB + 768 * 1024;
constexpr int CW_CNT = 16384;

constexpr int RING_BYTES = 131072;
constexpr int LDSCTL_OFF = RING_BYTES, MISC_OFF = LDSCTL_OFF + 320;
constexpr int LDS_BYTES = 147456;
constexpr int NWAVES = 8;

#define LDS_WAIT() asm volatile("s_waitcnt lgkmcnt(0)" ::: "memory")
#define VM_WAIT() asm volatile("s_waitcnt vmcnt(0)" ::: "memory")

__device__ __forceinline__ unsigned cvtpk(float lo, float hi) { f32x2_t v = {lo, hi}; bf16x2_t b = __builtin_convertvector(v, bf16x2_t); return __builtin_bit_cast(unsigned, b); }
__device__ __forceinline__ float sum_fq(float x) {
    auto a = __builtin_amdgcn_permlane16_swap(__float_as_uint(x), __float_as_uint(x), false, false); x = __uint_as_float(a[0]) + __uint_as_float(a[1]);
    auto b = __builtin_amdgcn_permlane32_swap(__float_as_uint(x), __float_as_uint(x), false, false); return __uint_as_float(b[0]) + __uint_as_float(b[1]); }
__device__ __forceinline__ float bflo(unsigned u) { return __builtin_bit_cast(float, u << 16); }
__device__ __forceinline__ float bfhi(unsigned u) { return __builtin_bit_cast(float, u & 0xffff0000u); }
typedef GAS unsigned char* gptr;
__device__ __forceinline__ gptr launder(unsigned char* p) { asm volatile("" : "+s"(p)); return (gptr)p; }
__device__ __forceinline__ float fsigmoid(float v) { return __builtin_amdgcn_rcpf(1.0f + __builtin_amdgcn_exp2f(-v * LOG2E)); }

namespace pg8 {
constexpr int BM = 256, BK = 64, HALF = 128, HTB = HALF * BK * 2, NXCD = 8, WGM = 8;
__host__ __device__ __forceinline__ int lds_byte(int r, int c) { const int st = (r >> 4) * 2 + (c >> 5), rr = r & 15, cc = c & 31, ob = rr * 64 + cc * 2; return st * 1024 + (ob ^ (((ob >> 9) & 1) << 5)); }
__host__ __device__ __forceinline__ void stage_rc(int b, int& R, int& C) { const int st = b / 1024, sb = b % 1024, swz = sb ^ (((sb >> 9) & 1) << 5); R = (st >> 1) * 16 + swz / 64; C = (st & 1) * 32 + (swz % 64) / 2; }
__host__ __device__ __forceinline__ int perm32(int rho) { const int n = rho >> 4, i = rho & 15; return 8 * (i >> 2) + 4 * n + (i & 3); }

struct Unit { int pm, pn, sub; };

__device__ __forceinline__ void tile_of(int L, int nM, int nN, int& pm, int& pn) {
    const int nwg = nM * nN; int wgid = L;
    { const int q = nwg / NXCD, r = nwg % NXCD, xcd = wgid % NXCD, off = wgid / NXCD; wgid = (xcd < r ? xcd * (q + 1) : r * (q + 1) + (xcd - r) * q) + off; }
    const int nig = WGM * nN, gid = wgid / nig, fm = gid * WGM, gsz = (nM - fm) < WGM ? (nM - fm) : WGM;
    pm = fm + ((wgid % nig) % gsz); pn = (wgid % nig) / gsz;
}

template <class P, int K>
__device__ __forceinline__ void gemm_phase(LAS unsigned char* lds, const P& p) {
    int tid_ = threadIdx.x; asm volatile("" : "+v"(tid_));
    const int tid = tid_, wid = __builtin_amdgcn_readfirstlane(tid >> 6), lane = tid & 63, wr = wid >> 2, wc = wid & 3, fr = lane & 15, fq = lane >> 4;
    constexpr int nt = K / BK;
    unsigned voffA[2], voffB[2];
#pragma unroll
    for (int i = 0; i < 2; ++i) { int R, C; stage_rc(tid * 16 + i * 8192, R, C); const int Rb = P::brow(R);
        voffA[i] = (unsigned)(R * K + C) * 2u; voffB[i] = (unsigned)(Rb * K + C) * 2u; }
    constexpr size_t kstep = (size_t)(BK * 2);
    constexpr size_t hstepA = (size_t)HALF * K * 2;
    constexpr size_t hstepB = (size_t)P::BHALF_ROWS * K * 2;
    const unsigned ldsw = (unsigned)wid * 1024u;
    const int aoff = lds_byte(wr * 64 + fr, fq * 8), boff = lds_byte(wc * 32 + fr, fq * 8);
#define PG8_SA(b, h) (((b) * 2 + (h)) * HTB)
#define PG8_SB(b, h) ((4 + (b) * 2 + (h)) * HTB)
#define PG8_STAGE(bufoff, gbase, voff) do { _Pragma("unroll") for (int _i = 0; _i < 2; ++_i) \
        __builtin_amdgcn_global_load_lds((const unsigned*)((const char*)(gbase) + (voff)[_i]), (LAS unsigned*)(lds + (bufoff) + ldsw + _i * 8192), 16, 0, 0); } while (0)
#define PG8_LDA(dst, b, h) do { _Pragma("unroll") for (int m = 0; m < 4; ++m) _Pragma("unroll") for (int k = 0; k < 2; ++k) dst[m][k] = *(const LAS bf16x8*)(lds + PG8_SA(b, h) + aoff + m * 2048 + k * 1024); } while (0)
#define PG8_LDB(dst, b, h) do { _Pragma("unroll") for (int n = 0; n < 2; ++n) _Pragma("unroll") for (int k = 0; k < 2; ++k) dst[n][k] = *(const LAS bf16x8*)(lds + PG8_SB(b, h) + boff + n * 2048 + k * 1024); } while (0)
#define PG8_MMA(ai, bj, At, Bt) do { __builtin_amdgcn_s_setprio(1); _Pragma("unroll") for (int m = 0; m < 4; ++m) _Pragma("unroll") for (int n = 0; n < 2; ++n) _Pragma("unroll") for (int k = 0; k < 2; ++k) \
        acc[ai][bj][m][n] = __builtin_amdgcn_mfma_f32_16x16x32_bf16(Bt[n][k], At[m][k], acc[ai][bj][m][n], 0, 0, 0); __builtin_amdgcn_s_setprio(0); } while (0)
#define PG8_WAIT_V(n) asm volatile("s_waitcnt vmcnt(" #n ")" ::: "memory")
#define PG8_WAIT_L(n) asm volatile("s_waitcnt lgkmcnt(" #n ")" ::: "memory")
#define PG8_BAR __builtin_amdgcn_s_barrier()
#define PG8_SCHED __builtin_amdgcn_sched_barrier(0)
    Unit cur, nxt; int ui = 0;
    if (!p.next(0, cur)) return;
    f32x4 acc[2][2][4][2];
#pragma unroll
    for (int a = 0; a < 2; ++a)
#pragma unroll
        for (int b = 0; b < 2; ++b)
#pragma unroll
            for (int m = 0; m < 4; ++m)
#pragma unroll
                for (int n = 0; n < 2; ++n) acc[a][b][m][n] = (f32x4){0.f, 0.f, 0.f, 0.f};
    bf16x8 At[4][2], B0[2][2], B1[2][2];
    p.a_ready(cur);
    const char* cA = p.aptr(cur); const char* cB = p.bptr(cur);
    PG8_STAGE(PG8_SB(0, 0), cB, voffB); PG8_STAGE(PG8_SB(0, 1), cB + hstepB, voffB); PG8_STAGE(PG8_SA(0, 0), cA, voffA); PG8_STAGE(PG8_SA(0, 1), cA + hstepA, voffA);
    if (wr == 1) PG8_BAR;
    PG8_WAIT_V(2); PG8_BAR;
    PG8_STAGE(PG8_SB(1, 0), cB + kstep, voffB); PG8_STAGE(PG8_SA(1, 0), cA + kstep, voffA); PG8_STAGE(PG8_SB(1, 1), cB + hstepB + kstep, voffB);
    PG8_WAIT_V(6); PG8_BAR;
    for (;;) {
        const bool has_next = p.next(ui + 1, nxt);
        const char* nA = has_next ? p.aptr(nxt) : cA; const char* nB = has_next ? p.bptr(nxt) : cB;
        for (int t = 0; t < nt; t += 2) {
            const bool last = (t == nt - 2);
            const char* a1 = cA + (size_t)(t + 1) * kstep;
            const char* a2 = last ? nA : cA + (size_t)(t + 2) * kstep; const char* b2 = last ? nB : cB + (size_t)(t + 2) * kstep;
            const char* a3 = a2 + kstep; const char* b3 = b2 + kstep;
            if (last && has_next) p.a_ready(nxt);
            PG8_LDB(B0, 0, 0); PG8_LDB(B1, 0, 1); PG8_SCHED; PG8_LDA(At, 0, 0); PG8_STAGE(PG8_SA(1, 1), a1 + hstepA, voffA);
            PG8_WAIT_V(8); PG8_WAIT_L(0); PG8_BAR; PG8_MMA(0, 0, At, B0); PG8_MMA(0, 1, At, B1); PG8_BAR; PG8_SCHED;
            PG8_LDA(At, 0, 1); PG8_STAGE(PG8_SB(0, 0), b2, voffB); PG8_STAGE(PG8_SB(0, 1), b2 + hstepB, voffB); PG8_STAGE(PG8_SA(0, 0), a2, voffA);
            PG8_WAIT_V(8); PG8_WAIT_L(0); PG8_BAR; PG8_MMA(1, 0, At, B0); PG8_MMA(1, 1, At, B1); PG8_BAR; PG8_SCHED;
            PG8_LDB(B0, 1, 0); PG8_LDB(B1, 1, 1); PG8_SCHED; PG8_LDA(At, 1, 0); PG8_STAGE(PG8_SA(0, 1), a2 + hstepA, voffA);
            PG8_WAIT_V(8); PG8_WAIT_L(0); PG8_BAR; PG8_MMA(0, 0, At, B0); PG8_MMA(0, 1, At, B1); PG8_BAR; PG8_SCHED;
            PG8_LDA(At, 1, 1); PG8_STAGE(PG8_SB(1, 0), b3, voffB); PG8_STAGE(PG8_SB(1, 1), b3 + hstepB, voffB); PG8_STAGE(PG8_SA(1, 0), a3, voffA);
            PG8_WAIT_V(8); PG8_WAIT_L(0); PG8_BAR; PG8_MMA(1, 0, At, B0); PG8_MMA(1, 1, At, B1); PG8_BAR; PG8_SCHED;
        }
        if (wr == 0) PG8_BAR;
        if constexpr (!P::AFTER_DRAIN) p.epi(acc, cur, wr, wc, fr, fq);
        if (!has_next) break;
        if (!p.keep(cur)) {
#pragma unroll
            for (int a = 0; a < 2; ++a)
#pragma unroll
                for (int b = 0; b < 2; ++b)
#pragma unroll
                    for (int m = 0; m < 4; ++m)
#pragma unroll
                        for (int n = 0; n < 2; ++n) acc[a][b][m][n] = (f32x4){0.f, 0.f, 0.f, 0.f};
        }
        cur = nxt; cA = nA; cB = nB; ++ui;
        if (wr == 1) PG8_BAR;
    }
    PG8_WAIT_V(0);
    PG8_BAR;
    if constexpr (P::AFTER_DRAIN) p.epi_drain(acc, cur, wr, wc, fr, fq, lds, wid, lane);
#undef PG8_SA
#undef PG8_SB
#undef PG8_STAGE
#undef PG8_LDA
#undef PG8_LDB
#undef PG8_MMA
#undef PG8_WAIT_V
#undef PG8_WAIT_L
#undef PG8_BAR
#undef PG8_SCHED
}
}

struct InProj {
    static constexpr int BHALF_ROWS = 16; static constexpr bool AFTER_DRAIN = false;
    __host__ __device__ static int brow(int R) { return 64 * (R >> 5) + 8 * (((R >> 2) & 1) + 4 * ((R >> 3) & 1)) + 4 * ((R >> 4) & 1) + (R & 3); }
    unsigned char* ws; int layer;
    int ctx_extra; unsigned* wcnt; unsigned wneed;
    int nM, nmain, G, c, i0, i1, single, extraL;
    __device__ __forceinline__ bool next(int i, pg8::Unit& u) const {
        u.sub = 0;
        if (single >= 0) { if (i != 0) return false; u.pm = 64 + single / 5; u.pn = single % 5; return true; }
        int nr = (nmain - c + G - 1) / G; nr = (nr < i1 ? nr : i1) - i0; nr = nr < 0 ? 0 : nr;
        int L;
        if (i < nr) L = (i + i0) * G + c; else if (i == nr && extraL >= 0) L = extraL;
        else if (ctx_extra >= 0 && i == nr + (extraL >= 0 ? 1 : 0)) { u.pm = 64 + ctx_extra / 5; u.pn = ctx_extra % 5; return true; }
        else return false;
        pg8::tile_of(L, nM, 21, u.pm, u.pn); return true;
    }
    __device__ __forceinline__ const char* aptr(const pg8::Unit& u) const { return (const char*)(ws + WS_HX) + (size_t)u.pm * 256 * DM * 2; }
    __device__ __forceinline__ const char* bptr(const pg8::Unit& u) const { return (const char*)(ws + WS_WIN) + ((size_t)layer * INC + (size_t)u.pn * 256) * DM * 2; }
    __device__ __forceinline__ void a_ready(const pg8::Unit& u) const {
        if (ctx_extra < 0 || u.pm < 64) return;
        if (threadIdx.x < 64) { unsigned sp = 0;
            while ((unsigned)__builtin_amdgcn_readfirstlane(__hip_atomic_load(wcnt, __ATOMIC_RELAXED, __HIP_MEMORY_SCOPE_AGENT)) < wneed) { __builtin_amdgcn_s_sleep(2); if (++sp > (1u << 22)) break; }
            __builtin_amdgcn_fence(__ATOMIC_ACQUIRE, "agent");
            asm volatile("s_waitcnt vmcnt(0)" ::: "memory"); }
        asm volatile("" ::: "memory"); __builtin_amdgcn_s_barrier(); asm volatile("" ::: "memory");
    }
    __device__ __forceinline__ bool keep(const pg8::Unit&) const { return false; }
    __device__ __forceinline__ void epi(f32x4 (&acc)[2][2][4][2], const pg8::Unit& u, int wr, int wc, int fr, int fq) const {
        const int pn = u.pn, pm = u.pm;
        gptr wl = launder(ws);
        GAS bf16_t* KA = (GAS bf16_t*)(wl + WS_KA); GAS bf16_t* VA = (GAS bf16_t*)(wl + WS_VA); GAS bf16_t* KB = (GAS bf16_t*)(wl + WS_KB); GAS bf16_t* VB = (GAS bf16_t*)(wl + WS_VB);
        GAS bf16_t* QA = (GAS bf16_t*)(wl + WS_QA); GAS bf16_t* QB = (GAS bf16_t*)(wl + WS_QB); GAS bf16_t* SZA = (GAS bf16_t*)(wl + WS_SZA); GAS bf16_t* SZB = (GAS bf16_t*)(wl + WS_SZB);
        GAS bf16_t* SGA = (GAS bf16_t*)(wl + WS_SGA); GAS bf16_t* SGB = (GAS bf16_t*)(wl + WS_SGB);
        const GAS float* nwt = (const GAS float*)(wl + WS_NW) + layer * 256; const GAS float* qna = nwt; const GAS float* kna = nwt + 64; const GAS float* qnb = nwt + 128; const GAS float* knb = nwt + 192;
        const GAS float* rope = (const GAS float*)(wl + WS_ROPE);
        const bool ctxrow = pm >= 64;
        const int kv0 = ctxrow ? (pm - 64) * KVR : ((pm >> 4) * KVR + CTXL + (pm & 15) * 256);
        const int c0 = (fq & 1) + 4 * (fq >> 1);
        const int hcol = 64 * wc;
        int type; GAS bf16_t* dst; int pitch, rowbase; const GAS float* nw = nullptr; bool rope_on = false; float osc = 1.f;
        if (pn < 2)       { type = 1; dst = KA + pn * 256 + hcol; pitch = 512; rowbase = kv0; nw = kna; }
        else if (pn < 4)  { type = 0; dst = VA + (pn - 2) * 256 + hcol; pitch = 512; rowbase = kv0; }
        else if (pn == 4) { if (wc < 2) { type = 1; dst = KB + hcol; pitch = 128; rowbase = kv0; nw = knb; rope_on = !ctxrow; }
                            else        { type = 0; dst = VB + (hcol - 128); pitch = 128; rowbase = kv0; } }
        else if (pn < 7)  { type = 1; dst = QA + (pn - 5) * 256 + hcol; pitch = QP; rowbase = pm * 256; nw = qna; osc = C2; }
        else if (pn < 9)  { type = 1; dst = QB + (pn - 7) * 256 + hcol; pitch = QP; rowbase = pm * 256; nw = qnb; rope_on = !ctxrow; osc = C2; }
        else if (pn < 11) { type = 2; dst = SZA + (pn - 9) * 256 + hcol; pitch = QP; rowbase = pm * 256; }
        else if (pn < 13) { type = 2; dst = SZB + (pn - 11) * 256 + hcol; pitch = QP; rowbase = pm * 256; }
        else if (pn < 17) { type = 3; dst = SGA + (pn - 13) * 256 + hcol; pitch = DM; rowbase = pm * 256; }
        else              { type = 3; dst = SGB + (pn - 17) * 256 + hcol; pitch = DM; rowbase = pm * 256; }
        float w[2][8];
        if (type == 1) {
#pragma unroll
            for (int bj = 0; bj < 2; ++bj) { const f32x4 a = *(const GAS f32x4*)(nw + 8 * (c0 + 2 * bj)), b = *(const GAS f32x4*)(nw + 8 * (c0 + 2 * bj) + 4);
                w[bj][0] = a[0] * osc; w[bj][1] = a[1] * osc; w[bj][2] = a[2] * osc; w[bj][3] = a[3] * osc; w[bj][4] = b[0] * osc; w[bj][5] = b[1] * osc; w[bj][6] = b[2] * osc; w[bj][7] = b[3] * osc; }
        }
#pragma unroll
        for (int ai = 0; ai < 2; ++ai)
#pragma unroll
            for (int m = 0; m < 4; ++m) {
                const int rr = 128 * ai + 64 * wr + 16 * m + fr;
                float v[2][8];
#pragma unroll
                for (int bj = 0; bj < 2; ++bj)
#pragma unroll
                    for (int n = 0; n < 2; ++n)
#pragma unroll
                        for (int e = 0; e < 4; ++e) v[bj][4 * n + e] = acc[ai][bj][m][n][e];
                if (type == 1) {
                    float ss = 0.f;
#pragma unroll
                    for (int bj = 0; bj < 2; ++bj)
#pragma unroll
                        for (int i = 0; i < 8; ++i) ss += v[bj][i] * v[bj][i];
                    ss = sum_fq(ss);
                    const float rinv = __builtin_amdgcn_rsqf(ss * (1.0f / 64.0f) + EPS);
#pragma unroll
                    for (int bj = 0; bj < 2; ++bj)
#pragma unroll
                        for (int i = 0; i < 8; ++i) v[bj][i] = v[bj][i] * rinv * w[bj][i];
                    if (rope_on) {
                        const int t = (pm & 15) * 256 + rr;
                        const int pos = (fq >> 1) ? (t & 63) : (t >> 6);
                        const GAS float* tb = rope + (size_t)(pos * 16 + 8 * (fq & 1)) * 2;
#pragma unroll
                        for (int q4 = 0; q4 < 4; ++q4) { const f32x4 cs = *(const GAS f32x4*)(tb + 4 * q4);
                            { const int i = 2 * q4; const float x1 = v[0][i], x2 = v[1][i]; v[0][i] = x1 * cs[0] - x2 * cs[1]; v[1][i] = x2 * cs[0] + x1 * cs[1]; }
                            { const int i = 2 * q4 + 1; const float x1 = v[0][i], x2 = v[1][i]; v[0][i] = x1 * cs[2] - x2 * cs[3]; v[1][i] = x2 * cs[2] + x1 * cs[3]; } }
                    }
                } else if (type == 2) {
#pragma unroll
                    for (int bj = 0; bj < 2; ++bj)
#pragma unroll
                        for (int i = 0; i < 8; ++i) v[bj][i] = v[bj][i] * fsigmoid(v[bj][i]);
                } else if (type == 3) {
#pragma unroll
                    for (int bj = 0; bj < 2; ++bj)
#pragma unroll
                        for (int i = 0; i < 8; ++i) v[bj][i] = fsigmoid(v[bj][i]);
                }
                GAS bf16_t* rowp = dst + (size_t)(rowbase + rr) * pitch;
#pragma unroll
                for (int bj = 0; bj < 2; ++bj) { u32x4 o; o.x = cvtpk(v[bj][0], v[bj][1]); o.y = cvtpk(v[bj][2], v[bj][3]); o.z = cvtpk(v[bj][4], v[bj][5]); o.w = cvtpk(v[bj][6], v[bj][7]);
                    if (type >= 2) __builtin_nontemporal_store(o, (GAS u32x4*)(rowp + 8 * (c0 + 2 * bj))); else *(GAS u32x4*)(rowp + 8 * (c0 + 2 * bj)) = o; }
            }
    }
};

struct MergeProj {
    static constexpr int BHALF_ROWS = 128; static constexpr bool AFTER_DRAIN = false;
    __host__ __device__ static int brow(int R) { return (R & ~31) + pg8::perm32(R & 31); }
    unsigned char* ws; int layer;
    int G, c, single;
    __device__ __forceinline__ bool next(int i, pg8::Unit& u) const {
        u.sub = i & 1;
        if (single >= 0) { if (i >= 2) return false; u.pm = 64 + single / 4; u.pn = single % 4; return true; }
        const int L = (i >> 1) * G + c; if (L >= 64 * 4) return false;
        pg8::tile_of(L, 64, 4, u.pm, u.pn); return true;
    }
    __device__ __forceinline__ const char* aptr(const pg8::Unit& u) const {
        return u.pm >= 64 ? (const char*)(ws + (u.sub ? WS_YCB : WS_YCA)) + (size_t)(u.pm - 64) * 256 * 512 * 2 : (const char*)(ws + (u.sub ? WS_YB : WS_YA)) + (size_t)u.pm * 256 * 512 * 2; }
    __device__ __forceinline__ const char* bptr(const pg8::Unit& u) const { return (const char*)(ws + (u.sub ? WS_WOB : WS_WOA)) + ((size_t)layer * DM + (size_t)u.pn * 256) * 512 * 2; }
    __device__ __forceinline__ bool keep(const pg8::Unit& u) const { return u.sub == 0; }
    __device__ __forceinline__ void a_ready(const pg8::Unit&) const {}
    __device__ __forceinline__ void epi(f32x4 (&acc)[2][2][4][2], const pg8::Unit& u, int wr, int wc, int fr, int fq) const {
        const int row0 = u.pm * 256 + wr * 64 + fr, col0 = u.pn * 256 + wc * 32 + 8 * fq;
        gptr wl = launder(ws);
        const GAS bf16_t* SGA = (const GAS bf16_t*)(wl + WS_SGA); const GAS bf16_t* SGB = (const GAS bf16_t*)(wl + WS_SGB); GAS bf16_t* MG = (GAS bf16_t*)(wl + WS_MG);
#pragma unroll
        for (int ai = 0; ai < 2; ++ai) {
            u32x4 sbv[4][2], sav[4][2];
#pragma unroll
            for (int m = 0; m < 4; ++m)
#pragma unroll
                for (int bj = 0; bj < 2; ++bj) { const size_t off = (size_t)(row0 + ai * 128 + m * 16) * DM + col0 + bj * 128;
                    sbv[m][bj] = *(const GAS u32x4*)(SGB + off); if (u.sub == 0) sav[m][bj] = *(const GAS u32x4*)(SGA + off); }
#pragma unroll
            for (int m = 0; m < 4; ++m) {
                const size_t off = (size_t)(row0 + ai * 128 + m * 16) * DM + col0;
#pragma unroll
                for (int bj = 0; bj < 2; ++bj) {
                    const u32x4 sb = sbv[m][bj];
                    float b[8] = {bflo(sb.x), bfhi(sb.x), bflo(sb.y), bfhi(sb.y), bflo(sb.z), bfhi(sb.z), bflo(sb.w), bfhi(sb.w)};
#pragma unroll
                    for (int i = 0; i < 8; ++i) b[i] = fmaxf(b[i], 1e-30f);
                    if (u.sub == 0) {
                        const u32x4 sa = sav[m][bj];
                        const float a[8] = {bflo(sa.x), bfhi(sa.x), bflo(sa.y), bfhi(sa.y), bflo(sa.z), bfhi(sa.z), bflo(sa.w), bfhi(sa.w)};
#pragma unroll
                        for (int n = 0; n < 2; ++n)
#pragma unroll
                            for (int e = 0; e < 4; ++e) acc[ai][bj][m][n][e] *= a[4 * n + e] * __builtin_amdgcn_rcpf(b[4 * n + e]);
                    } else {
                        float o[8];
#pragma unroll
                        for (int n = 0; n < 2; ++n)
#pragma unroll
                            for (int e = 0; e < 4; ++e) o[4 * n + e] = acc[ai][bj][m][n][e] * b[4 * n + e];
                        u32x4 w; w.x = cvtpk(o[0], o[1]); w.y = cvtpk(o[2], o[3]); w.z = cvtpk(o[4], o[5]); w.w = cvtpk(o[6], o[7]);
                        if (u.pm >= 64) *(GAS u32x4*)((GAS bf16_t*)(wl + WS_MGC) + off - (size_t)ML * DM + bj * 128) = w;
                        else *(GAS u32x4*)(MG + off + bj * 128) = w;
                    }
                }
            }
            asm volatile("" ::: "memory");
        }
    }
};

struct OutProj {
    static constexpr int BHALF_ROWS = 128; static constexpr bool AFTER_DRAIN = true;
    __host__ __device__ static int brow(int R) { return R; }
    unsigned char* ws; int layer; const GAS float* xin; GAS float* xout; const GAS float* cin;
    int G, c, single, fuse;
    int rmode;
    const GAS float* ng;
    __device__ __forceinline__ bool next(int i, pg8::Unit& u) const {
        u.sub = 0;
        if (single >= 0) { if (i != 0) return false; u.pm = 64 + single / 4; u.pn = single % 4; return true; }
        const int L = i * G + c; if (L >= 64 * 4 || i != 0) return false;
        pg8::tile_of(L, 64, 4, u.pm, u.pn); return true;
    }
    __device__ __forceinline__ const char* aptr(const pg8::Unit& u) const {
        return u.pm >= 64 ? (const char*)(ws + WS_MGC) + (size_t)(u.pm - 64) * 256 * DM * 2 : (const char*)(ws + WS_MG) + (size_t)u.pm * 256 * DM * 2; }
    __device__ __forceinline__ const char* bptr(const pg8::Unit& u) const { return (const char*)(ws + WS_WOUT) + ((size_t)layer * DM + (size_t)u.pn * 256) * DM * 2; }
    __device__ __forceinline__ void a_ready(const pg8::Unit&) const {}
    __device__ __forceinline__ bool keep(const pg8::Unit&) const { return false; }
    __device__ __forceinline__ void epi_drain(f32x4 (&acc)[2][2][4][2], const pg8::Unit& u, int wr, int wc, int fr, int fq, LAS unsigned char* lds, int wid, int lane) const {
        const bool ctxrow = u.pm >= 64;
        gptr wl = launder(ws);
        GAS float* cout = (GAS float*)(wl + WS_CTXN); const GAS float* mod = (const GAS float*)(wl + WS_MOD) + (size_t)layer * 5 * 3072;
        const GAS float* src = ctxrow ? cin + (size_t)(u.pm - 64) * 256 * DM : xin + (size_t)u.pm * 256 * DM;
        GAS float* dstp = ctxrow ? cout + (size_t)(u.pm - 64) * 256 * DM : xout + (size_t)u.pm * 256 * DM;
        const GAS float* gate = mod + (ctxrow ? 4 : (u.pm >> 4)) * 3072 + 2048;
        const int col0 = u.pn * 256 + wc * 32 + 4 * fq;
        {
            f32x4 gv[2][2];
#pragma unroll
            for (int bj = 0; bj < 2; ++bj)
#pragma unroll
                for (int n = 0; n < 2; ++n) gv[bj][n] = *(const GAS f32x4*)(gate + col0 + bj * 128 + n * 16);
            GAS bf16_t* x16 = (GAS bf16_t*)xout + (size_t)u.pm * 256 * 2048 + u.pn * 512 + wc * 32 + 4 * fq;
            if (rmode == 2) {
                int fr_ = fr; asm volatile("" : "+v"(fr_)); const int fr = fr_;
                { const GAS unsigned char* tsrc = (const GAS unsigned char*)xout + ((size_t)u.pm * 256 * 4096 + (size_t)u.pn * 1024);
#pragma unroll
                  for (int j = 0; j < 16; ++j) { const int r = 2 * (wid * 16 + j) + (lane >> 5), c = ((lane & 31) - r) & 31;
                      __builtin_amdgcn_global_load_lds((const GAS unsigned*)(tsrc + (size_t)r * 4096 + c * 16), (LAS unsigned*)(lds + (wid * 16 + j) * 1024), 16, 0, 0); } }
                asm volatile("s_waitcnt vmcnt(0)" ::: "memory"); __builtin_amdgcn_s_barrier(); asm volatile("" ::: "memory");
#pragma unroll
                for (int ai = 0; ai < 2; ++ai)
#pragma unroll
                    for (int m = 0; m < 4; ++m) { const int rr = ai * 128 + wr * 64 + m * 16 + fr; const size_t off = (size_t)rr * DM + col0;
#pragma unroll
                        for (int bj = 0; bj < 2; ++bj)
#pragma unroll
                            for (int n = 0; n < 2; ++n) { const int c = 4 * wc + 16 * bj + 2 * n + (fq >> 1);
                                const unsigned long long xr = *(const LAS unsigned long long*)(lds + rr * 512 + (((c + rr) & 31) << 4) + 8 * (fq & 1));
                                const unsigned lo = (unsigned)xr, hi = (unsigned)(xr >> 32);
                                const f32x4 xv = {bflo(lo), bfhi(lo), bflo(hi), bfhi(hi)};
                                __builtin_nontemporal_store(xv + gv[bj][n] * acc[ai][bj][m][n], (GAS f32x4*)(dstp + off + bj * 128 + n * 16)); } }
                return;
            } else if (rmode == 1) {
            int fr_ = fr; asm volatile("" : "+v"(fr_)); const int fr = fr_;
#pragma unroll
            for (int ai = 0; ai < 2; ++ai) {
                f32x4 xs[4][2][2];
#pragma unroll
                for (int m = 0; m < 4; ++m) { const size_t off = (size_t)(ai * 128 + wr * 64 + m * 16 + fr) * DM + col0;
#pragma unroll
                    for (int bj = 0; bj < 2; ++bj)
#pragma unroll
                        for (int n = 0; n < 2; ++n) xs[m][bj][n] = *(const GAS f32x4*)(src + off + bj * 128 + n * 16); }
#pragma unroll
                for (int m = 0; m < 4; ++m) {
#pragma unroll
                    for (int bj = 0; bj < 2; ++bj)
#pragma unroll
                        for (int n = 0; n < 2; ++n) { acc[ai][bj][m][n] = xs[m][bj][n] + gv[bj][n] * acc[ai][bj][m][n]; const f32x4 y = acc[ai][bj][m][n];
                            const int rr = ai * 128 + wr * 64 + m * 16 + fr, c = 4 * wc + 16 * bj + 2 * n + (fq >> 1);
                            *(LAS unsigned long long*)(lds + rr * 512 + (((c + rr) & 31) << 4) + 8 * (fq & 1)) = (unsigned long long)cvtpk(y[0], y[1]) | ((unsigned long long)cvtpk(y[2], y[3]) << 32); } }
                asm volatile("" ::: "memory");
            }
            asm volatile("s_waitcnt lgkmcnt(0)" ::: "memory"); __builtin_amdgcn_s_barrier(); asm volatile("" ::: "memory");
            { GAS unsigned char* tdst = (GAS unsigned char*)xout + ((size_t)u.pm * 256 * 4096 + (size_t)u.pn * 1024);
#pragma unroll
              for (int j = 0; j < 16; ++j) { const int r = 2 * (wid * 16 + j) + (lane >> 5), c = ((lane & 31) - r) & 31;
                  __builtin_nontemporal_store(*(const LAS u32x4*)(lds + (wid * 16 + j) * 1024 + lane * 16), (GAS u32x4*)(tdst + (size_t)r * 4096 + c * 16)); } }
            asm volatile("s_waitcnt lgkmcnt(0)" ::: "memory"); __builtin_amdgcn_s_barrier(); asm volatile("" ::: "memory");
            } else {
            int fr_ = fr; asm volatile("" : "+v"(fr_)); const int fr = fr_;
#pragma unroll
            for (int ai = 0; ai < 2; ++ai) {
                f32x4 xs[4][2][2];
#pragma unroll
                for (int m = 0; m < 4; ++m) { const size_t off = (size_t)(ai * 128 + wr * 64 + m * 16 + fr) * DM + col0;
#pragma unroll
                    for (int bj = 0; bj < 2; ++bj)
#pragma unroll
                        for (int n = 0; n < 2; ++n) xs[m][bj][n] = *(const GAS f32x4*)(src + off + bj * 128 + n * 16); }
#pragma unroll
                for (int m = 0; m < 4; ++m) { const size_t off = (size_t)(ai * 128 + wr * 64 + m * 16 + fr) * DM + col0;
#pragma unroll
                    for (int bj = 0; bj < 2; ++bj)
#pragma unroll
                        for (int n = 0; n < 2; ++n) *(GAS f32x4*)(dstp + off + bj * 128 + n * 16) = xs[m][bj][n] + gv[bj][n] * acc[ai][bj][m][n]; }
                asm volatile("" ::: "memory");
            }
            return;
            }
        }
        if (!fuse) return;
        const GAS float* md = (const GAS float*)(wl + WS_MOD) + (size_t)((layer + 1) * 5 + (u.pm >> 4)) * 3072;
        f32x4 gs[2][2], sh[2][2];
#pragma unroll
        for (int bj = 0; bj < 2; ++bj)
#pragma unroll
            for (int n = 0; n < 2; ++n) { const int cc = col0 + bj * 128 + n * 16;
                gs[bj][n] = *(const GAS f32x4*)(ng + cc) * (*(const GAS f32x4*)(md + 1024 + cc) + 1.0f); sh[bj][n] = *(const GAS f32x4*)(md + cc); }
        LAS float* Pp = (LAS float*)lds;
        LAS float* Sr = (LAS float*)(lds + 4096);
#pragma unroll
        for (int ai = 0; ai < 2; ++ai)
#pragma unroll
            for (int m = 0; m < 4; ++m) { float sq = 0.f;
#pragma unroll
                for (int bj = 0; bj < 2; ++bj)
#pragma unroll
                    for (int n = 0; n < 2; ++n) { const f32x4 x = acc[ai][bj][m][n]; sq += (x[0] * x[0] + x[1] * x[1]) + (x[2] * x[2] + x[3] * x[3]); }
                sq = sum_fq(sq);
                if (fq == 0) Pp[(ai * 128 + wr * 64 + m * 16 + fr) * 4 + wc] = sq; }
        asm volatile("s_waitcnt lgkmcnt(0)" ::: "memory"); __builtin_amdgcn_s_barrier(); asm volatile("" ::: "memory");
        const int row = wid * 32 + (lane & 31);
        GAS float* xb = (GAS float*)(wl + WS_XB) + ((size_t)u.pm * 256 + row) * 4;
        unsigned* pc = (unsigned*)(ws + WS_CTL) + CW_CNT + 64 * (16 + u.pm);
        if (lane < 32) { const float t4 = (Pp[row * 4 + 0] + Pp[row * 4 + 1]) + (Pp[row * 4 + 2] + Pp[row * 4 + 3]);
            __hip_atomic_store(xb + u.pn, t4, __ATOMIC_RELAXED, __HIP_MEMORY_SCOPE_AGENT); }
        asm volatile("s_waitcnt vmcnt(0)" ::: "memory");
        if (lane == 0) __hip_atomic_fetch_add(pc, 1u, __ATOMIC_RELAXED, __HIP_MEMORY_SCOPE_AGENT);
        if (wid == 0) { unsigned sp = 0;
            while ((unsigned)__builtin_amdgcn_readfirstlane(__hip_atomic_load(pc, __ATOMIC_RELAXED, __HIP_MEMORY_SCOPE_AGENT)) < 32u) { __builtin_amdgcn_s_sleep(2); if (++sp > (1u << 22)) break; }
            __builtin_amdgcn_fence(__ATOMIC_ACQUIRE, "agent"); }
        asm volatile("s_waitcnt vmcnt(0) lgkmcnt(0)" ::: "memory"); __builtin_amdgcn_s_barrier(); asm volatile("" ::: "memory");
        if (lane < 32) { float tot = 0.f;
#pragma unroll
            for (int t = 0; t < 4; ++t) tot += __hip_atomic_load(xb + t, __ATOMIC_RELAXED, __HIP_MEMORY_SCOPE_AGENT);
            Sr[row] = __builtin_amdgcn_rsqf(tot * (1.0f / DM) + EPS); }
        asm volatile("s_waitcnt vmcnt(0) lgkmcnt(0)" ::: "memory"); __builtin_amdgcn_s_barrier(); asm volatile("" ::: "memory");
        GAS bf16_t* HX = (GAS bf16_t*)(wl + WS_HX) + (size_t)u.pm * 256 * DM;
#pragma unroll
        for (int ai = 0; ai < 2; ++ai)
#pragma unroll
            for (int m = 0; m < 4; ++m) { const int rr = ai * 128 + wr * 64 + m * 16 + fr; const float r = Sr[rr];
#pragma unroll
                for (int bj = 0; bj < 2; ++bj)
#pragma unroll
                    for (int n = 0; n < 2; ++n) { const f32x4 y = acc[ai][bj][m][n] * r * gs[bj][n] + sh[bj][n];
                        *(GAS unsigned long long*)(HX + (size_t)rr * DM + col0 + bj * 128 + n * 16) = (unsigned long long)cvtpk(y[0], y[1]) | ((unsigned long long)cvtpk(y[2], y[3]) << 32); } }
    }
};

namespace attn_body {
constexpr int NW = 8, QBLK = 32, KVBLK = 64;
__device__ __forceinline__ int crow(int r, int hi) { return (r & 3) + 8 * (r >> 2) + 4 * hi; }
#define SBAR() __builtin_amdgcn_sched_barrier(0)
constexpr int NSLOT = 3, SLOTB = 8192;
constexpr int LDS_K = 0, LDS_V = NSLOT * SLOTB, LDS_WS = 2 * NSLOT * SLOTB, LDS_OST = LDS_WS + NW * 64 * 4, LDS_TAB = LDS_OST + NW * 4096, LDS_BYTES_A = LDS_TAB + 4096;
constexpr int TABM = 64, ZOFF = 640;
__device__ __forceinline__ void glds16(const GAS void* gsrc, unsigned lds_dst) { unsigned keep;
    asm volatile("s_mov_b32 %0, m0\n\ts_mov_b32 m0, %2\n\ts_nop 0\n\tglobal_load_lds_dwordx4 %1, off\n\ts_mov_b32 m0, %0" : "=&s"(keep) : "v"(gsrc), "s"(lds_dst) : "memory"); }
__device__ __forceinline__ float max3f(float a, float b, float c) { float r; asm("v_max3_f32 %0, %1, %2, %3" : "=v"(r) : "v"(a), "v"(b), "v"(c)); return r; }
__device__ __forceinline__ float max2f(float a, float b) { float r; asm("v_max_f32_e32 %0, %1, %2" : "=v"(r) : "v"(a), "v"(b)); return r; }
__device__ __forceinline__ float fadd_s(float a, float b) { float r; asm("v_add_f32_e32 %0, %1, %2" : "=v"(r) : "v"(a), "v"(b)); return r; }
__device__ __forceinline__ float fsub_s(float a, float b) { float r; asm("v_sub_f32_e32 %0, %1, %2" : "=v"(r) : "v"(a), "v"(b)); return r; }
#define WAIT_BAR(N) asm volatile("s_waitcnt vmcnt(" #N ") lgkmcnt(0)\n\ts_barrier" ::: "memory")

__device__ __forceinline__ void qkt(f32x16& p0, f32x16& p1, const char* Kslot, const bf16x8* qr, const f32x16& negm, int r32, int hi) {
    const char* kb = Kslot + hi * 1024 + r32 * 16;
#pragma unroll
    for (int d0 = 0; d0 < 4; ++d0) {
        const bf16x8 b0 = *reinterpret_cast<const bf16x8*>(kb + d0 * 2048);
        const bf16x8 b1 = *reinterpret_cast<const bf16x8*>(kb + d0 * 2048 + 512);
        if (d0 == 0) { p0 = __builtin_amdgcn_mfma_f32_32x32x16_bf16(b0, qr[0], negm, 0, 0, 0); p1 = __builtin_amdgcn_mfma_f32_32x32x16_bf16(b1, qr[0], negm, 0, 0, 0); }
        else { p0 = __builtin_amdgcn_mfma_f32_32x32x16_bf16(b0, qr[d0], p0, 0, 0, 0); p1 = __builtin_amdgcn_mfma_f32_32x32x16_bf16(b1, qr[d0], p1, 0, 0, 0); } }
}
typedef LAS const char* lds_cptr;
typedef short v4i16_t __attribute__((ext_vector_type(4)));
__device__ __forceinline__ void kload8(bf16x8* kf, lds_cptr kp) {
    kf[0] = *(const LAS bf16x8*)(kp);        kf[1] = *(const LAS bf16x8*)(kp + 512);
    kf[2] = *(const LAS bf16x8*)(kp + 2048); kf[3] = *(const LAS bf16x8*)(kp + 2560);
    kf[4] = *(const LAS bf16x8*)(kp + 4096); kf[5] = *(const LAS bf16x8*)(kp + 4608);
    kf[6] = *(const LAS bf16x8*)(kp + 6144); kf[7] = *(const LAS bf16x8*)(kp + 6656);
}
__device__ __forceinline__ void kload2(bf16x8* kf, lds_cptr kp, int j) { kf[2 * j] = *(const LAS bf16x8*)(kp + j * 2048); kf[2 * j + 1] = *(const LAS bf16x8*)(kp + j * 2048 + 512); }
__device__ __forceinline__ s16x4 vtr(lds_cptr p) { return __builtin_bit_cast(s16x4, __builtin_amdgcn_ds_read_tr16_b64_v4i16((LAS v4i16_t*)p)); }
__device__ __forceinline__ float rowmax(const f32x16& p0, const f32x16& p1) {
    float a = max3f(p0[0], p0[1], p1[0]), b = max3f(p0[2], p0[3], p1[1]); a = max3f(a, p1[2], p1[3]);
#pragma unroll
    for (int r = 4; r < 16; r += 4) { a = max3f(a, p0[r], p0[r + 1]); b = max3f(b, p0[r + 2], p0[r + 3]); a = max3f(a, p1[r], p1[r + 1]); b = max3f(b, p1[r + 2], p1[r + 3]); }
    const float m = max2f(a, b);
    auto rr = __builtin_amdgcn_permlane32_swap(__float_as_uint(m), __float_as_uint(m), false, false);
    return max2f(__uint_as_float(rr[0]), __uint_as_float(rr[1]));
}
__device__ __forceinline__ void pv(f32x16* o, int vb, bf16x8 pa0, bf16x8 pa1, bf16x8 pa2, bf16x8 pa3) {
#pragma unroll
    for (int d0 = 0; d0 < 2; ++d0) { s16x4 lo[4], hi[4];
#pragma unroll
        for (int ks = 0; ks < 4; ++ks) {
            asm volatile("ds_read_b64_tr_b16 %0,%1 offset:%c2" : "=&v"(lo[ks]) : "v"(vb), "i"(d0 * 4096 + ks * 1024) : "memory");
            asm volatile("ds_read_b64_tr_b16 %0,%1 offset:%c2" : "=&v"(hi[ks]) : "v"(vb), "i"(d0 * 4096 + ks * 1024 + 512) : "memory"); }
        asm volatile("s_waitcnt lgkmcnt(0)" ::: "memory"); SBAR();
#define PK(k) (bf16x8){lo[k][0], lo[k][1], lo[k][2], lo[k][3], hi[k][0], hi[k][1], hi[k][2], hi[k][3]}
        o[d0] = __builtin_amdgcn_mfma_f32_32x32x16_bf16(pa0, PK(0), o[d0], 0, 0, 0);
        o[d0] = __builtin_amdgcn_mfma_f32_32x32x16_bf16(pa1, PK(1), o[d0], 0, 0, 0);
        o[d0] = __builtin_amdgcn_mfma_f32_32x32x16_bf16(pa2, PK(2), o[d0], 0, 0, 0);
        o[d0] = __builtin_amdgcn_mfma_f32_32x32x16_bf16(pa3, PK(3), o[d0], 0, 0, 0);
#undef PK
    }
}

template <int MODE, int KP>
__device__ __forceinline__ void attn_unit(const GAS bf16_t* Qw0, const GAS bf16_t* Kh, const GAS bf16_t* Vh, const int NT, const int lo,
                                          GAS bf16_t* Ow0, const GAS bf16_t* Zw0, const int qr0, const GAS float* rpbh, char* shm) {
    int tid_ = threadIdx.x; asm volatile("" : "+v"(tid_));
    const int tid = tid_, lane = tid & 63, r32 = lane & 31, hi = lane >> 5; const int wid = __builtin_amdgcn_readfirstlane(tid >> 6);
    const GAS bf16_t* Qw = Qw0 + (long)(wid * QBLK) * QP;
    const unsigned lds0 = (unsigned)(uintptr_t)shm;
    float* wsf = (float*)(shm + LDS_WS) + wid * 64;
    const GAS bf16_t* ksrc = Kh + (long)lane * KP + wid * 8;
    const GAS bf16_t* vsrc = Vh + (long)(16 * (wid & 3) + (lane >> 2)) * KP + (wid >> 2) * 32 + (lane & 3) * 8;
    const unsigned kdst = lds0 + LDS_K + wid * 1024, vdst = lds0 + LDS_V + wid * 1024;
#define TMAP(t) ((MODE == 1 && (t) >= 4) ? (t) + lo : (t))
#define DMA_K(t, slot) glds16(ksrc + (long)TMAP(t) * KVBLK * KP, (unsigned)__builtin_amdgcn_readfirstlane(kdst + (slot)))
#define DMA_V(t, slot) glds16(vsrc + (long)TMAP(t) * KVBLK * KP, (unsigned)__builtin_amdgcn_readfirstlane(vdst + (slot)))
    const int vb0 = (int)(lds0 + LDS_V) + ((lane >> 4) & 1) * 32 + (lane & 3) * 8 + (4 * hi + ((lane & 15) >> 2)) * 64;
    const char* Kbase = shm + LDS_K; bf16x8 kf[8];
    const lds_cptr shm3 = (lds_cptr)shm; const lds_cptr kp0 = shm3 + LDS_K + hi * 1024 + r32 * 16; const lds_cptr vp0 = shm3 + LDS_V + ((lane >> 4) & 1) * 32 + (lane & 3) * 8 + (4 * hi + ((lane & 15) >> 2)) * 64;
    DMA_K(0, 0); DMA_V(0, 0); DMA_K(1, SLOTB);
    bf16x8 qr[4];
#pragma unroll
    for (int d0 = 0; d0 < 4; ++d0) qr[d0] = *(const GAS bf16x8*)(Qw + (long)r32 * QP + d0 * 16 + hi * 8);
    int na_qr = 0, na_rs = 0; const LAS float* na_tb = nullptr; const LAS float* na_tm = nullptr;
    if (MODE == 1) {
        LAS float* tab = (LAS float*)(shm3 + LDS_TAB);
        for (int i = tid; i < ZOFF + 128; i += NW * 64) { float v = 0.f;
            if (i >= ZOFF) v = (i - ZOFF >= 48 && i - ZOFF < 64) ? 0.f : -INFINITY;
            else if (i >= TABM && i < TABM + 15 * 32) { const int dr = (i - TABM) >> 5, dc = (i - TABM) & 31; if (dc < 31) v = rpbh[dr * 31 + dc] * LOG2E; }
            tab[i] = v; }
        na_qr = qr0 + (wid >> 1);
        na_rs = na_qr - 4; na_rs = na_rs < 0 ? 0 : (na_rs > 56 ? 56 : na_rs);
        const int qc = 32 * (wid & 1) + r32; int cs = qc - 8; cs = cs < 0 ? 0 : (cs > 48 ? 48 : cs);
        na_tb = (const LAS float*)(shm3 + LDS_TAB) + TABM + (4 * hi - qc + 15);
        na_tm = (const LAS float*)(shm3 + LDS_TAB) + ZOFF + (4 * hi - cs + 48);
    }
    float l_reg = 0.f; f32x16 o[2]; o[0] = f32x16{}; o[1] = f32x16{}; const f32x16 zc = f32x16{};
#define CMASK(P0, P1, t) do { if (MODE == 1 && (t) >= 4) { const float NEG_ = -INFINITY; const int kr_ = lo + (t) - 4; \
        if ((unsigned)(kr_ - na_rs) < 8u) { const LAS float* tb_ = na_tb + (kr_ - na_qr + 7) * 32; const LAS float* tm_ = na_tm; asm volatile("" : "+v"(tm_)); \
            _Pragma("unroll") for (int g_ = 0; g_ < 4; ++g_) { \
              _Pragma("unroll") for (int r = 4 * g_; r < 4 * g_ + 4; ++r) { const int kc_ = (r & 3) + 8 * (r >> 2); \
                P0[r] += tb_[kc_] + tm_[kc_]; P1[r] += tb_[kc_ + 32] + tm_[kc_ + 32]; } \
              asm volatile("" : "+v"(P0), "+v"(P1)); SBAR(); } } \
        else { _Pragma("unroll") for (int r = 0; r < 16; ++r) { P0[r] = NEG_; P1[r] = NEG_; } } } } while (0)
    f32x16 pA0, pA1, pB0, pB1;
    int sl_prev = 0, sl_cur = 0, sl_next = SLOTB;
#define ROT() do { sl_prev = sl_cur; sl_cur = sl_next; sl_next = (sl_next == (NSLOT - 1) * SLOTB) ? 0 : sl_next + SLOTB; } while (0)
    DMA_K(2, 2 * SLOTB);
    WAIT_BAR(3);
    qkt(pA0, pA1, Kbase, qr, zc, r32, hi); asm volatile("s_nop 15\n\ts_nop 7" : "+v"(pA0), "+v"(pA1));
    _Pragma("unroll") for (int r = 0; r < 16; ++r) pA0[r] = __builtin_amdgcn_exp2f(pA0[r]);
    _Pragma("unroll") for (int r = 0; r < 16; ++r) pA1[r] = __builtin_amdgcn_exp2f(pA1[r]);
    WAIT_BAR(0);
    DMA_K(3, 0); DMA_V(1, SLOTB);
    ROT();
    kload8(kf, kp0 + sl_cur);
    WAIT_BAR(2);
    s16x4 vlo[8], vhi[8]; u32x4 pw0, pw1, pw2, pw3;
#define PKW(P, B) cvtpk(P[B], P[B + 1])
#define PAF(k) __builtin_bit_cast(bf16x8, pw##k)
#define VFR(i) (bf16x8){vlo[i][0], vlo[i][1], vlo[i][2], vlo[i][3], vhi[i][0], vhi[i][1], vhi[i][2], vhi[i][3]}
#define PIN(x) asm volatile("" : "+v"(x))
#define GAPA(MF, A0, A1, A2, A3, W0, W1, PW) do { __builtin_amdgcn_s_setprio(1); MF; __builtin_amdgcn_s_setprio(0); sacc += A0; sacc += A1; sacc += A2; sacc += A3; PIN(sacc); W0; W1; PIN(PW); SBAR(); } while (0)
#define EX(v) __builtin_amdgcn_exp2f(v)
#define GAPB(MF, X, B) do { __builtin_amdgcn_s_setprio(1); MF; __builtin_amdgcn_s_setprio(0); X[B] = EX(X[B]); X[B + 1] = EX(X[B + 1]); X[B + 2] = EX(X[B + 2]); X[B + 3] = EX(X[B + 3]); PIN(X); SBAR(); } while (0)
#define VRD(i) do { vlo[i] = vtr(vp_ + (((i) >> 2) * 4096 + ((i) & 3) * 1024)); vhi[i] = vtr(vp_ + (((i) >> 2) * 4096 + ((i) & 3) * 1024 + 512)); } while (0)
#define KRD(G, j) do { if (G) { kload2(kf, kp0 + sl_next, j); SBAR(); } } while (0)
#define STEP(C0, C1, P0, P1, t, GK, GV, GL) do { SBAR(); \
    const lds_cptr vp_ = vp0 + sl_prev; \
    VRD(0); SBAR(); float sacc = (P0[0] + P0[1]); \
    GAPA(C0 = __builtin_amdgcn_mfma_f32_32x32x16_bf16(kf[0], qr[0], zc, 0, 0, 0), P0[2], P0[3], P0[4], P0[5],     pw0[0] = PKW(P0, 0), pw0[1] = PKW(P0, 2), pw0); \
    VRD(4); SBAR(); GAPA(C1 = __builtin_amdgcn_mfma_f32_32x32x16_bf16(kf[1], qr[0], zc, 0, 0, 0), P0[6], P0[7], P0[8], P0[9],     pw0[2] = PKW(P0, 4), pw0[3] = PKW(P0, 6), pw0); \
    VRD(1); SBAR(); GAPA(C0 = __builtin_amdgcn_mfma_f32_32x32x16_bf16(kf[2], qr[1], C0, 0, 0, 0),   P0[10], P0[11], P0[12], P0[13], pw1[0] = PKW(P0, 8), pw1[1] = PKW(P0, 10), pw1); \
    VRD(5); SBAR(); GAPA(C1 = __builtin_amdgcn_mfma_f32_32x32x16_bf16(kf[3], qr[1], C1, 0, 0, 0),   P0[14], P0[15], P1[0], P1[1],   pw1[2] = PKW(P0, 12), pw1[3] = PKW(P0, 14), pw1); \
    VRD(2); SBAR(); GAPA(C0 = __builtin_amdgcn_mfma_f32_32x32x16_bf16(kf[4], qr[2], C0, 0, 0, 0),   P1[2], P1[3], P1[4], P1[5],     pw2[0] = PKW(P1, 0), pw2[1] = PKW(P1, 2), pw2); \
    VRD(6); SBAR(); GAPA(C1 = __builtin_amdgcn_mfma_f32_32x32x16_bf16(kf[5], qr[2], C1, 0, 0, 0),   P1[6], P1[7], P1[8], P1[9],     pw2[2] = PKW(P1, 4), pw2[3] = PKW(P1, 6), pw2); \
    VRD(3); SBAR(); GAPA(C0 = __builtin_amdgcn_mfma_f32_32x32x16_bf16(kf[6], qr[3], C0, 0, 0, 0),   P1[10], P1[11], P1[12], P1[13], pw3[0] = PKW(P1, 8), pw3[1] = PKW(P1, 10), pw3); \
    VRD(7); SBAR(); GAPA(C1 = __builtin_amdgcn_mfma_f32_32x32x16_bf16(kf[7], qr[3], C1, 0, 0, 0),   P1[14], P1[15], 0.f, 0.f,       pw3[2] = PKW(P1, 12), pw3[3] = PKW(P1, 14), pw3); \
    l_reg += sacc; \
    if (GK) { DMA_K((t) + 3, sl_cur); } if (GV) { DMA_V((t) + 1, sl_next); } \
    CMASK(C0, C1, t); \
    SBAR(); \
    GAPB(o[0] = __builtin_amdgcn_mfma_f32_32x32x16_bf16(PAF(0), VFR(0), o[0], 0, 0, 0), C0, 0); \
    GAPB(o[1] = __builtin_amdgcn_mfma_f32_32x32x16_bf16(PAF(0), VFR(4), o[1], 0, 0, 0), C0, 4); \
    KRD(GL, 0); GAPB(o[0] = __builtin_amdgcn_mfma_f32_32x32x16_bf16(PAF(1), VFR(1), o[0], 0, 0, 0), C0, 8); \
    KRD(GL, 1); GAPB(o[1] = __builtin_amdgcn_mfma_f32_32x32x16_bf16(PAF(1), VFR(5), o[1], 0, 0, 0), C0, 12); \
    KRD(GL, 2); GAPB(o[0] = __builtin_amdgcn_mfma_f32_32x32x16_bf16(PAF(2), VFR(2), o[0], 0, 0, 0), C1, 0); \
    KRD(GL, 3); GAPB(o[1] = __builtin_amdgcn_mfma_f32_32x32x16_bf16(PAF(2), VFR(6), o[1], 0, 0, 0), C1, 4); \
    GAPB(o[0] = __builtin_amdgcn_mfma_f32_32x32x16_bf16(PAF(3), VFR(3), o[0], 0, 0, 0), C1, 8); \
    GAPB(o[1] = __builtin_amdgcn_mfma_f32_32x32x16_bf16(PAF(3), VFR(7), o[1], 0, 0, 0), C1, 12); \
    } while (0)
    int t = 1;
    for (; t + 5 < NT; t += 2) {
        STEP(pB0, pB1, pA0, pA1, t, true, true, true);     WAIT_BAR(2); ROT();
        STEP(pA0, pA1, pB0, pB1, t + 1, true, true, true); WAIT_BAR(2); ROT();
    }
#define ENDW(tt) do { if ((tt) + 3 < NT) { WAIT_BAR(2); } else if ((tt) + 2 < NT) { WAIT_BAR(1); } else { WAIT_BAR(0); } } while (0)
    for (; t + 1 < NT; t += 2) {
        STEP(pB0, pB1, pA0, pA1, t, (t + 3 < NT), (t + 1 < NT), (t + 1 < NT));         ENDW(t);     ROT();
        STEP(pA0, pA1, pB0, pB1, t + 1, (t + 4 < NT), (t + 2 < NT), (t + 2 < NT));     ENDW(t + 1); ROT();
    }
#define DRAIN(PX0, PX1, SLOT) do { float sacc = PX0[0] + PX0[1]; _Pragma("unroll") for (int r = 2; r < 16; ++r) sacc += PX0[r]; _Pragma("unroll") for (int r = 0; r < 16; ++r) sacc += PX1[r]; l_reg += sacc; \
      pw0 = (u32x4){PKW(PX0, 0), PKW(PX0, 2), PKW(PX0, 4), PKW(PX0, 6)}; pw1 = (u32x4){PKW(PX0, 8), PKW(PX0, 10), PKW(PX0, 12), PKW(PX0, 14)}; pw2 = (u32x4){PKW(PX1, 0), PKW(PX1, 2), PKW(PX1, 4), PKW(PX1, 6)}; pw3 = (u32x4){PKW(PX1, 8), PKW(PX1, 10), PKW(PX1, 12), PKW(PX1, 14)}; \
      SBAR(); pv(o, vb0 + (SLOT), PAF(0), PAF(1), PAF(2), PAF(3)); } while (0)
    if (t < NT) { STEP(pB0, pB1, pA0, pA1, NT - 1, false, false, false); DRAIN(pB0, pB1, sl_cur); }
    else { DRAIN(pA0, pA1, sl_prev); }
#undef DRAIN
#undef PKW
#undef PAF
#undef VFR
#undef PIN
#undef GAPA
#undef GAPB
#undef EX
#undef VRD
#undef KRD
#undef STEP
#undef ENDW
    { auto rr = __builtin_amdgcn_permlane32_swap(__float_as_uint(l_reg), __float_as_uint(l_reg), false, false); l_reg = __uint_as_float(rr[0]) + __uint_as_float(rr[1]); }
    if (hi == 0) wsf[32 + r32] = l_reg; asm volatile("s_waitcnt lgkmcnt(0)" ::: "memory");
    float rli[16];
#pragma unroll
    for (int r = 0; r < 16; ++r) rli[r] = __builtin_amdgcn_rcpf(wsf[32 + crow(r, hi)]);
    GAS bf16_t* Ow = Ow0 + (long)(wid * QBLK) * QP; const GAS bf16_t* Zw = Zw0 + (long)(wid * QBLK) * QP;
    { __hip_bfloat16* stg = (__hip_bfloat16*)(shm + LDS_OST) + wid * 2048;
#pragma unroll
      for (int r = 0; r < 16; ++r) { const int orow = crow(r, hi);
#pragma unroll
        for (int d0 = 0; d0 < 2; ++d0) stg[orow * 64 + d0 * 32 + r32] = __float2bfloat16(o[d0][r] * rli[r]); }
      asm volatile("s_waitcnt lgkmcnt(0)" ::: "memory");
#pragma unroll
      for (int i = 0; i < 4; ++i) { const int row = i * 8 + (lane >> 3), ch = lane & 7; const u32x4 v = *(const u32x4*)(stg + row * 64 + ch * 8);
        const u32x4 z = *(const GAS u32x4*)(Zw + (long)row * QP + ch * 8); u32x4 y;
        y.x = cvtpk(bflo(v.x) * bflo(z.x), bfhi(v.x) * bfhi(z.x)); y.y = cvtpk(bflo(v.y) * bflo(z.y), bfhi(v.y) * bfhi(z.y));
        y.z = cvtpk(bflo(v.z) * bflo(z.z), bfhi(v.z) * bfhi(z.z)); y.w = cvtpk(bflo(v.w) * bflo(z.w), bfhi(v.w) * bfhi(z.w));
        *(GAS u32x4*)(Ow + (long)row * QP + ch * 8) = y; } }
    asm volatile("s_waitcnt lgkmcnt(0)\n\ts_barrier" ::: "memory");
#undef DMA_K
#undef DMA_V
#undef TMAP
#undef CMASK
#undef ROT
}
#undef SBAR
#undef WAIT_BAR
}

#define XB_TMO      128
#define XB_XCNT(j)  (256  + 64 * (j))
#define XB_XSUB(j)  (1280 + 64 * (j))
#define XB_XGEN(j)  (2304 + 64 * (j))
#define XB_TOP      3328
#define XB_TOPGEN   3392
#define XCD_BAR_WORDS 3456
#define XB_SPIN_CAP (1u << 18)
__device__ __forceinline__ unsigned xb_ld(unsigned* p)              { return __hip_atomic_load(p, __ATOMIC_RELAXED, __HIP_MEMORY_SCOPE_AGENT); }
__device__ __forceinline__ unsigned xb_add(unsigned* p, unsigned v) { return __hip_atomic_fetch_add(p, v, __ATOMIC_RELAXED, __HIP_MEMORY_SCOPE_AGENT); }
__device__ __forceinline__ unsigned xb_xcc_id() { return (unsigned)__builtin_amdgcn_s_getreg((3 << 11) | 20) & 0xFu; }
#define XB_SPIN(cond, bar) do { unsigned _sp = 0; while (cond) { __builtin_amdgcn_s_sleep(1); \
    if ((++_sp & 255u) == 0u) { if (xb_ld(&(bar)[XB_TMO])) break; if (_sp > XB_SPIN_CAP) { atomicAdd(&(bar)[XB_TMO], 1u); break; } } } } while (0)
struct XcdBarrier { unsigned* bar; unsigned x; volatile LAS unsigned* st; };
__device__ __forceinline__ XcdBarrier xcd_barrier_post(unsigned* bar, volatile LAS unsigned* st) {
    XcdBarrier b; b.bar = bar; b.x = xb_xcc_id(); b.st = st;
    if (threadIdx.x == 0) (void)xb_add(&bar[XB_XCNT(b.x)], 1u);
    return b;
}
__device__ __forceinline__ void xcd_barrier_complete(unsigned* bar, unsigned x, unsigned& nloc, unsigned& nx) {
    const unsigned G = gridDim.x * gridDim.y * gridDim.z;
    unsigned sum, cnt, mine, sp = 0u;
    for (;;) {
        sum = 0u; cnt = 0u; mine = 0u;
#pragma unroll
        for (unsigned j = 0; j < 16; ++j) { const unsigned c = xb_ld(&bar[XB_XCNT(j)]); sum += c; cnt += (c > 0u) ? 1u : 0u; mine = (j == x) ? c : mine; }
        if (sum == G) break;
        __builtin_amdgcn_s_sleep(1);
        if ((++sp & 255u) == 0u) { if (xb_ld(&bar[XB_TMO])) break; if (sp > XB_SPIN_CAP) { atomicAdd(&bar[XB_TMO], 1u); break; } }
    }
    nloc = mine > 0u ? mine : 1u; nx = cnt > 0u ? cnt : 1u;
}
__device__ __forceinline__ void xcd_barrier(const XcdBarrier& b) {
    asm volatile("s_waitcnt vmcnt(0)" ::: "memory");
    __syncthreads();
    if (threadIdx.x == 0) {
        unsigned* bar = b.bar;
        __builtin_amdgcn_s_waitcnt(0);
        unsigned nloc = b.st[0], nx = b.st[1];
        if (nloc == 0u) { xcd_barrier_complete(bar, b.x, nloc, nx); b.st[0] = nloc; b.st[1] = nx; }
        const unsigned old = xb_add(&bar[XB_XSUB(b.x)], 1u);
        const unsigned gen = old / nloc;
        if (old + 1u == (gen + 1u) * nloc) {
            __builtin_amdgcn_fence(__ATOMIC_RELEASE, "agent");
            asm volatile("s_waitcnt vmcnt(0)" ::: "memory");
            const unsigned og = xb_add(&bar[XB_TOP], 1u);
            const unsigned tg = og / nx;
            if (og + 1u == (tg + 1u) * nx) xb_add(&bar[XB_TOPGEN], 1u);
            else XB_SPIN(xb_ld(&bar[XB_TOPGEN]) == tg, bar);
            __builtin_amdgcn_fence(__ATOMIC_ACQUIRE, "agent");
            xb_add(&bar[XB_XGEN(b.x)], 1u);
            asm volatile("s_waitcnt vmcnt(0)" ::: "memory");
        } else {
            XB_SPIN(xb_ld(&bar[XB_XGEN(b.x)]) == gen, bar);
            __builtin_amdgcn_fence(__ATOMIC_ACQUIRE, "agent");
            asm volatile("s_waitcnt vmcnt(0)" ::: "memory");
        }
    }
    __syncthreads();
}

__device__ __forceinline__ float wave_sum(float v) {
#pragma unroll
    for (int o = 1; o < 64; o <<= 1) v += __shfl_xor(v, o);
    return v;
}
__device__ __forceinline__ void p0_transpose_item(const float* W, int K, int N, bf16_t* WT, LAS float* scr, int item, int lane) {
    const int nblk = N / 32, kb = item / nblk, nb = item % nblk, k0 = 64 * kb, n0 = 32 * nb;
#pragma unroll 8
    for (int i = 0; i < 32; ++i) { const int kk = 2 * i + (lane >> 5); scr[kk * 33 + (lane & 31)] = __builtin_nontemporal_load(W + (size_t)(k0 + kk) * N + n0 + (lane & 31)); }
    LDS_WAIT(); asm volatile("" ::: "memory");
    const int c = lane & 7;
#pragma unroll
    for (int j = 0; j < 4; ++j) { const int n = (lane >> 3) + 8 * j; const LAS float* s = scr + (8 * c) * 33 + n;
        u32x4 o; o.x = cvtpk(s[0 * 33], s[1 * 33]); o.y = cvtpk(s[2 * 33], s[3 * 33]); o.z = cvtpk(s[4 * 33], s[5 * 33]); o.w = cvtpk(s[6 * 33], s[7 * 33]);
        *(GAS u32x4*)(WT + (size_t)(n0 + n) * K + k0 + 8 * c) = o; }
    LDS_WAIT(); asm volatile("" ::: "memory");
}

#ifndef DUP_PHASE
#define DUP_PHASE -1
#endif
struct Args { const float* in[16]; float* out; unsigned char* ws; };

__device__ __forceinline__ void p1_rows(const GAS float* x, const GAS float* cx, const GAS float* g, const GAS float* mod, GAS bf16_t* HX, int m0, int m1, int mstep, int lane) {
    for (int m = m0; m < m1; m += mstep) {
        const bool isc = m >= ML;
        const GAS float* xrow = isc ? cx + (size_t)(m - ML) * DM : x + (size_t)m * DM;
        const GAS float* md = mod + (isc ? 4 : (m >> 12)) * 3072;
        const GAS f32x4* xr = (const GAS f32x4*)xrow + lane;
        f32x4 v[4]; float s = 0.f;
#pragma unroll
        for (int j = 0; j < 4; ++j) { v[j] = __builtin_nontemporal_load(xr + 64 * j); s += (v[j].x * v[j].x + v[j].y * v[j].y) + (v[j].z * v[j].z + v[j].w * v[j].w); }
        const float r = __builtin_amdgcn_rsqf(wave_sum(s) * (1.f / DM) + EPS);
        GAS unsigned long long* o8 = (GAS unsigned long long*)(HX + (size_t)m * DM) + lane;
#pragma unroll
        for (int j = 0; j < 4; ++j) {
            const f32x4 gg = *((const GAS f32x4*)g + lane + 64 * j), sh = *((const GAS f32x4*)md + lane + 64 * j), sc = *((const GAS f32x4*)(md + 1024) + lane + 64 * j);
            const f32x4 y = v[j] * r * gg * (sc + 1.0f) + sh;
            o8[64 * j] = (unsigned long long)cvtpk(y.x, y.y) | ((unsigned long long)cvtpk(y.z, y.w) << 32);
        }
    }
}

__global__ void __launch_bounds__(NWAVES * 64, 2) dit_fwd(Args args) {
    extern __shared__ __attribute__((aligned(16))) unsigned char lds_raw[];
    LAS unsigned char* lds = (LAS unsigned char*)lds_raw;
    volatile LAS unsigned* MISC = (volatile LAS unsigned*)(lds + MISC_OFF);
    const int tid = threadIdx.x, lane = tid & 63, wave = __builtin_amdgcn_readfirstlane(tid >> 6);
    const int G = gridDim.x; const int bx = blockIdx.x; const int vcu = (G % 8 == 0) ? (bx % 8) * (G / 8) + bx / 8 : bx;
    unsigned char* ws = args.ws;
    unsigned* ctl = (unsigned*)(ws + WS_CTL);
    for (int u = tid; u < (LDS_BYTES - LDSCTL_OFF) / 4; u += NWAVES * 64) ((LAS unsigned*)(lds + LDSCTL_OFF))[u] = 0u;
    __syncthreads();
    XcdBarrier bar = xcd_barrier_post(ctl + CW_BAR, MISC + 8);

    float* out = args.out;
    const int gw = vcu * NWAVES + wave, NGW = G * NWAVES;

    {
        const float* c_in = args.in[1]; const float* cctx = args.in[3]; const float* w_ada = args.in[4]; const float* b_ada = args.in[5];
        float* MOD = (float*)(ws + WS_MOD); float* ROPE = (float*)(ws + WS_ROPE); float* NWT = (float*)(ws + WS_NW);
        for (int task = vcu; task < 193; task += G) if (task < 192) {
            LAS float* sc = (LAS float*)lds;
            LAS float* red = (LAS float*)(lds + 20480);
            for (int i = tid; i < 5 * 1024; i += NWAVES * 64) { const float cv = (i < 4096) ? c_in[i] : cctx[i - 4096]; sc[i] = cv * fsigmoid(cv); }
            __syncthreads();
            const int l = task / 96, n0 = (task % 96) * 32, col = lane & 31, kh = lane >> 5;
            const float* wp = w_ada + (size_t)l * 1024 * 3072 + n0 + col;
            float a0 = 0.f, a1 = 0.f, a2 = 0.f, a3 = 0.f, a4 = 0.f;
            const int kbase = 128 * wave + 64 * kh;
#pragma unroll 8
            for (int i = 0; i < 64; ++i) { const int k = kbase + i; const float wv = wp[(size_t)k * 3072];
                a0 += sc[k] * wv; a1 += sc[1024 + k] * wv; a2 += sc[2048 + k] * wv; a3 += sc[3072 + k] * wv; a4 += sc[4096 + k] * wv; }
            const int slot = wave * 2 + kh;
            red[(slot * 5 + 0) * 32 + col] = a0; red[(slot * 5 + 1) * 32 + col] = a1; red[(slot * 5 + 2) * 32 + col] = a2; red[(slot * 5 + 3) * 32 + col] = a3; red[(slot * 5 + 4) * 32 + col] = a4;
            __syncthreads();
            if (tid < 160) { const int r = tid >> 5, cc = tid & 31; float sm = 0.f;
                for (int sl = 0; sl < 16; ++sl) sm += red[(sl * 5 + r) * 32 + cc];
                MOD[(size_t)(l * 5 + r) * 3072 + n0 + cc] = sm + b_ada[l * 3072 + n0 + cc]; }
            asm volatile("s_waitcnt vmcnt(0)" ::: "memory"); __syncthreads();
            if (tid == 0) { __builtin_amdgcn_fence(__ATOMIC_RELEASE, "agent"); asm volatile("s_waitcnt vmcnt(0)" ::: "memory"); (void)xb_add(ctl + CW_CNT + 64 * 12, 1u); }
        } else {
            for (int i = tid; i < 64 * 16; i += NWAVES * 64) { const int pos = i >> 4, j = i & 15;
                const float inv = 1.0f / powf(10000.0f, (float)j / 16.0f); const float ang = (float)pos * inv;
                ROPE[2 * i] = cosf(ang); ROPE[2 * i + 1] = sinf(ang); }
            if (tid < 512) { const int l = tid >> 8, w = (tid >> 6) & 3, d = tid & 63; NWT[tid] = args.in[8 + w][l * 64 + d]; }
        }
        const float* w_in = args.in[7]; const float* w_o_a = args.in[13]; const float* w_o_b = args.in[14]; const float* w_out = args.in[15];
        bf16_t* WIN = (bf16_t*)(ws + WS_WIN); bf16_t* WOA = (bf16_t*)(ws + WS_WOA); bf16_t* WOB = (bf16_t*)(ws + WS_WOB); bf16_t* WOUT = (bf16_t*)(ws + WS_WOUT);
        LAS float* scr = (LAS float*)(lds + 32768 + wave * 8704);
        constexpr int I_IN = (DM / 64) * (INC / 32), I_O = (512 / 64) * (DM / 32), I_OUT = (DM / 64) * (DM / 32), I_L = I_IN + 2 * I_O + I_OUT;
        for (int it = gw; it < 2 * I_L; it += NGW) {
            const int l = it / I_L; int r = it % I_L;
            if (r < I_IN) { p0_transpose_item(w_in + (size_t)l * DM * INC, DM, INC, WIN + (size_t)l * INC * DM, scr, r, lane); continue; } r -= I_IN;
            if (r < I_O) { p0_transpose_item(w_o_a + (size_t)l * 512 * DM, 512, DM, WOA + (size_t)l * DM * 512, scr, r, lane); continue; } r -= I_O;
            if (r < I_O) { p0_transpose_item(w_o_b + (size_t)l * 512 * DM, 512, DM, WOB + (size_t)l * DM * 512, scr, r, lane); continue; } r -= I_O;
            p0_transpose_item(w_out + (size_t)l * DM * DM, DM, DM, WOUT + (size_t)l * DM * DM, scr, r, lane);
        }
    }

    enum { K_NONE = 0, K_P1, K_INPROJ, K_ATTN, K_MERGE, K_OUT };
    unsigned* cnt = ctl + CW_CNT;
    for (int step = 0; step < 12; ++step) {
        int kind = K_NONE, layer = step >= 5 ? 1 : 0, i0 = 0, i1 = 1 << 20, single = -1, waitc = -1, sigc = -1, extraL = -1, ctx_extra = -1; unsigned need = 4u;
        int m0 = 0, m1 = 0, mstep = 1;
        bool bar_after = true;
        switch (step) {
            case 0: kind = K_P1; m0 = gw; m1 = MT; mstep = NGW; waitc = 12; need = 192u; break;
            case 1: kind = K_INPROJ; break;
            case 2: kind = K_ATTN; break;
            case 3: kind = K_MERGE; break;
            case 4: kind = K_OUT; break;
            case 5: kind = K_NONE; bar_after = false; break;
            case 6: bar_after = false;
                if (bx >= 64 && bx < 80) { kind = K_MERGE; layer = 0; single = bx - 64; sigc = (bx - 64) >> 2; }
                else { kind = K_INPROJ; if (bx >= 80 && bx < 96) i1 = 2; else if (bx >= 164 && bx < 228) i1 = 4;
                       else if (bx >= 112 && bx < 132) ctx_extra = bx - 112;
                       else if (bx >= 132 && bx < 148) extraL = 4 * G + 64 + (bx - 132);
                       else if (bx >= 148 && bx < 164) extraL = 4 * G + 80 + (bx - 148); }
                break;
            case 7: bar_after = false;
                if (bx >= 64 && bx < 80) { kind = K_INPROJ; i1 = 4; }
                else if (bx >= 80 && bx < 96) { kind = K_OUT; layer = 0; single = bx - 80; waitc = (bx - 80) >> 2; sigc = 4 + ((bx - 80) >> 2); }
                else if (bx >= 164 && bx < 228) { kind = K_P1; m0 = ML + (bx - 164) * 16 + wave; m1 = ML + (bx - 164) * 16 + 16; mstep = NWAVES; waitc = 4 + ((bx - 164) >> 4); sigc = 8 + ((bx - 164) >> 4); }
                break;
            case 8:
                if (bx >= 80 && bx < 96) { kind = K_INPROJ; i0 = 2; i1 = 4; } else if (bx >= 164 && bx < 228) { kind = K_INPROJ; i0 = 4; }
                break;
            case 9: kind = K_ATTN; break;
            case 10: kind = K_MERGE; break;
            default: kind = K_OUT; bar_after = false; break;
        }
        const bool upd = (layer == 0);
        if (waitc >= 0) {
            if (tid == 0) { unsigned sp = 0; while (xb_ld(cnt + 64 * waitc) < need) { __builtin_amdgcn_s_sleep(2); if (++sp > (1u << 22)) break; }
                __builtin_amdgcn_fence(__ATOMIC_ACQUIRE, "agent"); asm volatile("s_waitcnt vmcnt(0)" ::: "memory"); }
            __syncthreads();
        }
        switch (kind) {
        case K_P1: {
            gptr wl = launder(ws); int lane_ = threadIdx.x & 63; asm volatile("" : "+v"(lane_));
            const GAS float* xl = layer == 0 ? (const GAS float*)args.in[0] : (const GAS float*)out;
            const GAS float* cl = layer == 0 ? (const GAS float*)args.in[2] : (const GAS float*)(wl + WS_CTXN);
            p1_rows(xl, cl, (const GAS float*)args.in[6] + layer * DM, (const GAS float*)(wl + WS_MOD) + (size_t)layer * 5 * 3072, (GAS bf16_t*)(wl + WS_HX), m0, m1, mstep, lane_);
        } break;
        case K_INPROJ: {
            InProj p; p.ws = ws; p.layer = layer; p.nM = upd ? 68 : 64; p.nmain = p.nM * 21; p.G = G; p.c = bx; p.i0 = i0; p.i1 = i1; p.single = single; p.extraL = extraL; p.ctx_extra = ctx_extra; p.wcnt = cnt + 64 * (8 + (ctx_extra >= 0 ? ctx_extra / 5 : 0)); p.wneed = 16u;
            pg8::gemm_phase<InProj, DM>(lds, p);
        } break;
        case K_ATTN: {
            char* shm = (char*)lds_raw;
            for (int ug = vcu; ug < 512; ug += G) {
                const int i = ug >> 8, x8 = (ug >> 5) & 7, j = ug & 31;
                const int b = x8 >> 1, kh = x8 & 1, h = kh * 4 + (j >> 3), qb = (j & 7) * 2 + i;
                const size_t qoff = ((size_t)b * SEQ + qb * 256) * QP + h * 64; const size_t koff = (size_t)b * KVR * 128 + kh * 64;
                gptr wl = launder(ws);
                GAS bf16_t* QB = (GAS bf16_t*)(wl + WS_QB); const GAS bf16_t* KB = (const GAS bf16_t*)(wl + WS_KB); const GAS bf16_t* VB = (const GAS bf16_t*)(wl + WS_VB); const GAS bf16_t* SZB = (const GAS bf16_t*)(wl + WS_SZB);
                attn_body::attn_unit<0, 128>(QB + qoff, KB + koff, VB + koff, KVR / 64, 0, (GAS bf16_t*)(wl + WS_YB) + qoff, SZB + qoff, 0, (const GAS float*)nullptr, shm);
            }
            for (int un = vcu; un < 512; un += G) {
                const int i = un >> 8, x8 = (un >> 5) & 7, j = un & 31;
                const int bh = x8 * 4 + (j >> 3), b = bh >> 3, h = bh & 7, qb = (j & 7) * 2 + i;
                int lo = 4 * qb - 4; lo = lo < 0 ? 0 : (lo > 56 ? 56 : lo);
                int hi = 4 * qb - 1; hi = hi < 0 ? 0 : (hi > 56 ? 56 : hi); hi += 7;
                const int nrow = hi - lo + 1;
                const size_t qoff = ((size_t)b * SEQ + qb * 256) * QP + h * 64; const size_t koff = (size_t)b * KVR * 512 + h * 64;
                gptr wl = launder(ws);
                GAS bf16_t* QA = (GAS bf16_t*)(wl + WS_QA); const GAS bf16_t* KA = (const GAS bf16_t*)(wl + WS_KA); const GAS bf16_t* VA = (const GAS bf16_t*)(wl + WS_VA); const GAS bf16_t* SZA = (const GAS bf16_t*)(wl + WS_SZA);
                attn_body::attn_unit<1, 512>(QA + qoff, KA + koff, VA + koff, 4 + nrow, lo, (GAS bf16_t*)(wl + WS_YA) + qoff, SZA + qoff, 4 * qb, (const GAS float*)args.in[12] + ((size_t)layer * 8 + h) * 15 * 31, shm);
            }
            if (upd) for (int uc = vcu; uc < 256; uc += G) if ((uc & 7) == 0 || (uc & 7) == 7) {
                const int id = (uc >> 3) * 2 + ((uc & 7) == 7 ? 1 : 0), br = id >> 5, bh = id & 31, b = bh >> 3, h = bh & 7;
                const size_t qoff = ((size_t)ML + b * CTXL) * QP + h * 64, yoff = ((size_t)b * CTXL) * QP + h * 64;
                gptr wl = launder(ws);
                if (br == 0) { const size_t koff = (size_t)b * KVR * 512 + h * 64;
                    GAS bf16_t* QA = (GAS bf16_t*)(wl + WS_QA); const GAS bf16_t* KA = (const GAS bf16_t*)(wl + WS_KA); const GAS bf16_t* VA = (const GAS bf16_t*)(wl + WS_VA); const GAS bf16_t* SZA = (const GAS bf16_t*)(wl + WS_SZA);
                    attn_body::attn_unit<0, 512>(QA + qoff, KA + koff, VA + koff, 4, 0, (GAS bf16_t*)(wl + WS_YCA) + yoff, SZA + qoff, 0, (const GAS float*)nullptr, shm); }
                else { const size_t koff = (size_t)b * KVR * 128 + (h >> 2) * 64;
                    GAS bf16_t* QB = (GAS bf16_t*)(wl + WS_QB); const GAS bf16_t* KB = (const GAS bf16_t*)(wl + WS_KB); const GAS bf16_t* VB = (const GAS bf16_t*)(wl + WS_VB); const GAS bf16_t* SZB = (const GAS bf16_t*)(wl + WS_SZB);
                    attn_body::attn_unit<0, 128>(QB + qoff, KB + koff, VB + koff, 4, 0, (GAS bf16_t*)(wl + WS_YCB) + yoff, SZB + qoff, 0, (const GAS float*)nullptr, shm); }
            }
        } break;
        case K_MERGE: {
            MergeProj p; p.ws = ws; p.layer = layer; p.G = G; p.c = bx; p.single = single;
            pg8::gemm_phase<MergeProj, 512>(lds, p);
        } break;
        case K_OUT: {
            OutProj p; p.ws = ws; p.layer = layer; p.xin = layer == 0 ? (const GAS float*)args.in[0] : (const GAS float*)out; p.xout = (GAS float*)out; p.cin = (const GAS float*)args.in[2]; p.G = G; p.c = bx; p.single = single;
            p.fuse = (step == 4) ? 1 : 0; p.rmode = single >= 0 ? 0 : (layer == 0 ? 1 : 2); p.ng = (const GAS float*)args.in[6] + DM;
            pg8::gemm_phase<OutProj, DM>(lds, p);
        } break;
        default: break;
        }
        if (sigc >= 0) {
            asm volatile("s_waitcnt vmcnt(0)" ::: "memory"); __syncthreads();
            if (tid == 0) { __builtin_amdgcn_fence(__ATOMIC_RELEASE, "agent"); asm volatile("s_waitcnt vmcnt(0)" ::: "memory"); (void)xb_add(cnt + 64 * sigc, 1u); }
        }
        if (bar_after) xcd_barrier(bar);
    }
}

extern "C" void kernel_launch(void* const* d_in, const int* in_sizes, int n_in, void* d_out, int out_size, void* d_ws, size_t ws_size, hipStream_t stream) {
    static int grid = 0;
    if (grid == 0) {
        if (n_in != 16 || out_size != ML * DM || ws_size < WS_USED) { fprintf(stderr, "kernel_launch: unexpected problem (n_in %d out %d ws %zu)\n", n_in, out_size, ws_size); grid = -1; return; }
        int dev = 0, cus = 0, per_cu = 0;
        if (hipGetDevice(&dev) != hipSuccess || hipDeviceGetAttribute(&cus, hipDeviceAttributeMultiprocessorCount, dev) != hipSuccess) { grid = -1; return; }
        if (hipFuncSetAttribute((const void*)dit_fwd, hipFuncAttributeMaxDynamicSharedMemorySize, LDS_BYTES) != hipSuccess) { fprintf(stderr, "kernel_launch: hipFuncSetAttribute failed\n"); grid = -1; return; }
        if (hipOccupancyMaxActiveBlocksPerMultiprocessor(&per_cu, (const void*)dit_fwd, NWAVES * 64, LDS_BYTES) != hipSuccess || per_cu < 1) { fprintf(stderr, "kernel_launch: occupancy query says %d\n", per_cu); per_cu = 1; }
        (void)hipGetLastError();
        grid = cus;
        if (grid != 256) fprintf(stderr, "kernel_launch: %d CUs; the static unit maps assume 256\n", grid);
    }
    if (grid < 0) return;
    (void)hipMemsetAsync((char*)d_ws + WS_CTL, 0, CTL_ZERO_BYTES, stream);
    Args a{};
    for (int i = 0; i < 16; ++i) a.in[i] = (const float*)d_in[i];
    a.out = (float*)d_out; a.ws = (unsigned char*)d_ws;
    hipLaunchKernelGGL(dit_fwd, dim3(grid), dim3(NWAVES * 64), LDS_BYTES, stream, a);
}
```

```cpp
#include <hip/hip_runtime.h>
#include <hip/hip_bf16.h>
#include <cstdio>
#include <cstdint>
#include <cmath>

#define LAS __attribute__((address_space(3)))
#define GAS __attribute__((address_space(1)))
typedef unsigned short bf16_t;
typedef short bf16x8 __attribute__((ext_vector_type(8)));
typedef short s16x4 __attribute__((ext_vector_type(4)));
typedef float f32x4 __attribute__((ext_vector_type(4)));
typedef float f32x16 __attribute__((ext_vector_type(16)));
typedef unsigned u32x4 __attribute__((ext_vector_type(4)));
typedef float f32x2_t __attribute__((ext_vector_type(2)));
typedef __bf16 bf16x2_t __attribute__((ext_vector_type(2)));

constexpr int DM = 1024, NB = 4, SEQ = 4096, CTXL = 256, HD = 64;
constexpr int ML = NB * SEQ;
constexpr int MC = NB * CTXL;
constexpr int MT = ML + MC;
constexpr int INC = 5376;
constexpr int KVR = CTXL + SEQ;
constexpr int QP = 512;
constexpr float EPS = 1e-6f;
constexpr float LOG2E = 1.4426950408889634f;
constexpr float C2 = 0.125f * LOG2E;

constexpr size_t MiB = 1u << 20;
constexpr size_t WS_CTL = 0, CTL_ZERO_BYTES = 128 * 1024;
constexpr size_t WS_MOD = 1 * MiB;
constexpr size_t WS_ROPE = 1 * MiB + 256 * 1024;
constexpr size_t WS_NW = 1 * MiB + 512 * 1024;
constexpr size_t WS_WIN = 2 * MiB;
constexpr size_t WS_WOA = 23 * MiB;
constexpr size_t WS_WOB = 25 * MiB;
constexpr size_t WS_WOUT = 27 * MiB;
constexpr size_t WS_CTXN = 31 * MiB;
constexpr size_t WS_HX = 36 * MiB;
constexpr size_t WS_KA = 70 * MiB;
constexpr size_t WS_VA = 87 * MiB;
constexpr size_t WS_KB = 104 * MiB;
constexpr size_t WS_VB = 109 * MiB;
constexpr size_t WS_QA = 114 * MiB;
constexpr size_t WS_QB = 131 * MiB;
constexpr size_t WS_SZA = 148 * MiB;
constexpr size_t WS_SZB = 165 * MiB;
constexpr size_t WS_SGA = 182 * MiB;
constexpr size_t WS_SGB = 216 * MiB;
constexpr size_t WS_END = 250 * MiB;
constexpr size_t WS_YA = WS_HX, WS_YB = WS_HX + 17 * MiB;
constexpr size_t WS_MG = WS_QA;
constexpr size_t WS_YCA = 250 * MiB, WS_YCB = 251 * MiB;
constexpr size_t WS_MGC = 252 * MiB;
constexpr size_t WS_USED = 254 * MiB;
constexpr int CW_BAR = 4096;
constexpr size_t WS_XB = 1 * MiB + 768 * 1024;
constexpr int CW_CNT = 16384;

constexpr int RING_BYTES = 131072;
constexpr int LDSCTL_OFF = RING_BYTES, MISC_OFF = LDSCTL_OFF + 320;
constexpr int LDS_BYTES = 147456;
constexpr int PP_OFF = RING_BYTES + 2048;
constexpr int NWAVES = 8;

#define LDS_WAIT() asm volatile("s_waitcnt lgkmcnt(0)" ::: "memory")
#define VM_WAIT() asm volatile("s_waitcnt vmcnt(0)" ::: "memory")

__device__ __forceinline__ unsigned cvtpk(float lo, float hi) { f32x2_t v = {lo, hi}; bf16x2_t b = __builtin_convertvector(v, bf16x2_t); return __builtin_bit_cast(unsigned, b); }
__device__ __forceinline__ float sum_fq(float x) {
    auto a = __builtin_amdgcn_permlane16_swap(__float_as_uint(x), __float_as_uint(x), false, false); x = __uint_as_float(a[0]) + __uint_as_float(a[1]);
    auto b = __builtin_amdgcn_permlane32_swap(__float_as_uint(x), __float_as_uint(x), false, false); return __uint_as_float(b[0]) + __uint_as_float(b[1]); }
__device__ __forceinline__ float bflo(unsigned u) { return __builtin_bit_cast(float, u << 16); }
__device__ __forceinline__ float bfhi(unsigned u) { return __builtin_bit_cast(float, u & 0xffff0000u); }
typedef GAS unsigned char* gptr;
__device__ __forceinline__ gptr launder(unsigned char* p) { asm volatile("" : "+s"(p)); return (gptr)p; }
__device__ __forceinline__ float fsigmoid(float v) { return __builtin_amdgcn_rcpf(1.0f + __builtin_amdgcn_exp2f(-v * LOG2E)); }

namespace pg8 {
constexpr int BM = 256, BK = 64, HALF = 128, HTB = HALF * BK * 2, NXCD = 8, WGM = 8;
__host__ __device__ __forceinline__ int lds_byte(int r, int c) { const int st = (r >> 4) * 2 + (c >> 5), rr = r & 15, cc = c & 31, ob = rr * 64 + cc * 2; return st * 1024 + (ob ^ (((ob >> 9) & 1) << 5)); }
__host__ __device__ __forceinline__ void stage_rc(int b, int& R, int& C) { const int st = b / 1024, sb = b % 1024, swz = sb ^ (((sb >> 9) & 1) << 5); R = (st >> 1) * 16 + swz / 64; C = (st & 1) * 32 + (swz % 64) / 2; }
__host__ __device__ __forceinline__ int perm32(int rho) { const int n = rho >> 4, i = rho & 15; return 8 * (i >> 2) + 4 * n + (i & 3); }

struct Unit { int pm, pn, sub; };

__device__ __forceinline__ void tile_of(int L, int nM, int nN, int& pm, int& pn) {
    const int nwg = nM * nN; int wgid = L;
    { const int q = nwg / NXCD, r = nwg % NXCD, xcd = wgid % NXCD, off = wgid / NXCD; wgid = (xcd < r ? xcd * (q + 1) : r * (q + 1) + (xcd - r) * q) + off; }
    const int nig = WGM * nN, gid = wgid / nig, fm = gid * WGM, gsz = (nM - fm) < WGM ? (nM - fm) : WGM;
    pm = fm + ((wgid % nig) % gsz); pn = (wgid % nig) / gsz;
}

template <class P, int K>
__device__ __forceinline__ void gemm_phase(LAS unsigned char* lds, const P& p) {
    int tid_ = threadIdx.x; asm volatile("" : "+v"(tid_));
    const int tid = tid_, wid = __builtin_amdgcn_readfirstlane(tid >> 6), lane = tid & 63, wr = wid >> 2, wc = wid & 3, fr = lane & 15, fq = lane >> 4;
    constexpr int nt = K / BK;
    unsigned voffA[2], voffB[2];
#pragma unroll
    for (int i = 0; i < 2; ++i) { int R, C; stage_rc(tid * 16 + i * 8192, R, C); const int Rb = P::brow(R);
        voffA[i] = (unsigned)(R * K + C) * 2u; voffB[i] = (unsigned)(Rb * K + C) * 2u; }
    constexpr size_t kstep = (size_t)(BK * 2);
    constexpr size_t hstepA = (size_t)HALF * K * 2;
    constexpr size_t hstepB = (size_t)P::BHALF_ROWS * K * 2;
    const unsigned ldsw = (unsigned)wid * 1024u;
    const int aoff = lds_byte(wr * 64 + fr, fq * 8), boff = lds_byte(wc * 32 + fr, fq * 8);
#define PG8_SA(b, h) (((b) * 2 + (h)) * HTB)
#define PG8_SB(b, h) ((4 + (b) * 2 + (h)) * HTB)
#define PG8_STAGE(bufoff, gbase, voff) do { _Pragma("unroll") for (int _i = 0; _i < 2; ++_i) \
        __builtin_amdgcn_global_load_lds((const unsigned*)((const char*)(gbase) + (voff)[_i]), (LAS unsigned*)(lds + (bufoff) + ldsw + _i * 8192), 16, 0, 0); } while (0)
#define PG8_LDA(dst, b, h) do { _Pragma("unroll") for (int m = 0; m < 4; ++m) _Pragma("unroll") for (int k = 0; k < 2; ++k) dst[m][k] = *(const LAS bf16x8*)(lds + PG8_SA(b, h) + aoff + m * 2048 + k * 1024); } while (0)
#define PG8_LDB(dst, b, h) do { _Pragma("unroll") for (int n = 0; n < 2; ++n) _Pragma("unroll") for (int k = 0; k < 2; ++k) dst[n][k] = *(const LAS bf16x8*)(lds + PG8_SB(b, h) + boff + n * 2048 + k * 1024); } while (0)
#define PG8_MMA(ai, bj, At, Bt) do { __builtin_amdgcn_s_setprio(1); _Pragma("unroll") for (int m = 0; m < 4; ++m) _Pragma("unroll") for (int n = 0; n < 2; ++n) _Pragma("unroll") for (int k = 0; k < 2; ++k) \
        acc[ai][bj][m][n] = __builtin_amdgcn_mfma_f32_16x16x32_bf16(Bt[n][k], At[m][k], acc[ai][bj][m][n], 0, 0, 0); __builtin_amdgcn_s_setprio(0); } while (0)
#define PG8_WAIT_V(n) asm volatile("s_waitcnt vmcnt(" #n ")" ::: "memory")
#define PG8_WAIT_L(n) asm volatile("s_waitcnt lgkmcnt(" #n ")" ::: "memory")
#define PG8_BAR __builtin_amdgcn_s_barrier()
#define PG8_SCHED __builtin_amdgcn_sched_barrier(0)
    Unit cur, nxt; int ui = 0;
    if (!p.next(0, cur)) return;
    f32x4 acc[2][2][4][2];
#pragma unroll
    for (int a = 0; a < 2; ++a)
#pragma unroll
        for (int b = 0; b < 2; ++b)
#pragma unroll
            for (int m = 0; m < 4; ++m)
#pragma unroll
                for (int n = 0; n < 2; ++n) acc[a][b][m][n] = (f32x4){0.f, 0.f, 0.f, 0.f};
    bf16x8 At[4][2], B0[2][2], B1[2][2];
    p.a_ready(cur);
    const char* cA = p.aptr(cur); const char* cB = p.bptr(cur);
    PG8_STAGE(PG8_SB(0, 0), cB, voffB); PG8_STAGE(PG8_SB(0, 1), cB + hstepB, voffB); PG8_STAGE(PG8_SA(0, 0), cA, voffA); PG8_STAGE(PG8_SA(0, 1), cA + hstepA, voffA);
    if (wr == 1) PG8_BAR;
    PG8_WAIT_V(2); PG8_BAR;
    PG8_STAGE(PG8_SB(1, 0), cB + kstep, voffB); PG8_STAGE(PG8_SA(1, 0), cA + kstep, voffA); PG8_STAGE(PG8_SB(1, 1), cB + hstepB + kstep, voffB);
    PG8_WAIT_V(6); PG8_BAR;
    for (;;) {
        const bool has_next = p.next(ui + 1, nxt);
        const char* nA = has_next ? p.aptr(nxt) : cA; const char* nB = has_next ? p.bptr(nxt) : cB;
        for (int t = 0; t < nt; t += 2) {
            const bool last = (t == nt - 2);
            const char* a1 = cA + (size_t)(t + 1) * kstep;
            const char* a2 = last ? nA : cA + (size_t)(t + 2) * kstep; const char* b2 = last ? nB : cB + (size_t)(t + 2) * kstep;
            const char* a3 = a2 + kstep; const char* b3 = b2 + kstep;
            if (last && has_next) p.a_ready(nxt);
            PG8_LDB(B0, 0, 0); PG8_LDB(B1, 0, 1); PG8_SCHED; PG8_LDA(At, 0, 0); PG8_STAGE(PG8_SA(1, 1), a1 + hstepA, voffA);
            PG8_WAIT_V(8); PG8_WAIT_L(0); PG8_BAR; PG8_MMA(0, 0, At, B0); PG8_MMA(0, 1, At, B1); PG8_BAR; PG8_SCHED;
            PG8_LDA(At, 0, 1); PG8_STAGE(PG8_SB(0, 0), b2, voffB); PG8_STAGE(PG8_SB(0, 1), b2 + hstepB, voffB); PG8_STAGE(PG8_SA(0, 0), a2, voffA);
            PG8_WAIT_V(8); PG8_WAIT_L(0); PG8_BAR; PG8_MMA(1, 0, At, B0); PG8_MMA(1, 1, At, B1); PG8_BAR; PG8_SCHED;
            PG8_LDB(B0, 1, 0); PG8_LDB(B1, 1, 1); PG8_SCHED; PG8_LDA(At, 1, 0); PG8_STAGE(PG8_SA(0, 1), a2 + hstepA, voffA);
            PG8_WAIT_V(8); PG8_WAIT_L(0); PG8_BAR; PG8_MMA(0, 0, At, B0); PG8_MMA(0, 1, At, B1); PG8_BAR; PG8_SCHED;
            PG8_LDA(At, 1, 1); PG8_STAGE(PG8_SB(1, 0), b3, voffB); PG8_STAGE(PG8_SB(1, 1), b3 + hstepB, voffB); PG8_STAGE(PG8_SA(1, 0), a3, voffA);
            PG8_WAIT_V(8); PG8_WAIT_L(0); PG8_BAR; PG8_MMA(1, 0, At, B0); PG8_MMA(1, 1, At, B1); PG8_BAR; PG8_SCHED;
        }
        if (wr == 0) PG8_BAR;
        if constexpr (!P::AFTER_DRAIN) p.epi(acc, cur, wr, wc, fr, fq);
        if (!has_next) break;
        if (!p.keep(cur)) {
#pragma unroll
            for (int a = 0; a < 2; ++a)
#pragma unroll
                for (int b = 0; b < 2; ++b)
#pragma unroll
                    for (int m = 0; m < 4; ++m)
#pragma unroll
                        for (int n = 0; n < 2; ++n) acc[a][b][m][n] = (f32x4){0.f, 0.f, 0.f, 0.f};
        }
        cur = nxt; cA = nA; cB = nB; ++ui;
        if (wr == 1) PG8_BAR;
    }
    PG8_WAIT_V(0);
    PG8_BAR;
    if constexpr (P::AFTER_DRAIN) p.epi_drain(acc, cur, wr, wc, fr, fq, lds, wid, lane);
#undef PG8_SA
#undef PG8_SB
#undef PG8_STAGE
#undef PG8_LDA
#undef PG8_LDB
#undef PG8_MMA
#undef PG8_WAIT_V
#undef PG8_WAIT_L
#undef PG8_BAR
#undef PG8_SCHED
}
}

struct InProj {
    static constexpr int BHALF_ROWS = 16; static constexpr bool AFTER_DRAIN = false;
    __host__ __device__ static int brow(int R) { return 64 * (R >> 5) + 8 * (((R >> 2) & 1) + 4 * ((R >> 3) & 1)) + 4 * ((R >> 4) & 1) + (R & 3); }
    unsigned char* ws; int layer;
    int ctx_extra; unsigned* wcnt; unsigned wneed;
    int nM, nmain, G, c, i0, i1, single, extraL;
    __device__ __forceinline__ bool next(int i, pg8::Unit& u) const {
        u.sub = 0;
        if (single >= 0) { if (i != 0) return false; u.pm = 64 + single / 5; u.pn = single % 5; return true; }
        int nr = (nmain - c + G - 1) / G; nr = (nr < i1 ? nr : i1) - i0; nr = nr < 0 ? 0 : nr;
        int L;
        if (i < nr) L = (i + i0) * G + c; else if (i == nr && extraL >= 0) L = extraL;
        else if (ctx_extra >= 0 && i == nr + (extraL >= 0 ? 1 : 0)) { u.pm = 64 + ctx_extra / 5; u.pn = ctx_extra % 5; return true; }
        else return false;
        pg8::tile_of(L, nM, 21, u.pm, u.pn); return true;
    }
    __device__ __forceinline__ const char* aptr(const pg8::Unit& u) const { return (const char*)(ws + WS_HX) + (size_t)u.pm * 256 * DM * 2; }
    __device__ __forceinline__ const char* bptr(const pg8::Unit& u) const { return (const char*)(ws + WS_WIN) + ((size_t)layer * INC + (size_t)u.pn * 256) * DM * 2; }
    __device__ __forceinline__ void a_ready(const pg8::Unit& u) const {
        if (ctx_extra < 0 || u.pm < 64) return;
        if (threadIdx.x < 64) { unsigned sp = 0;
            while ((unsigned)__builtin_amdgcn_readfirstlane(__hip_atomic_load(wcnt, __ATOMIC_RELAXED, __HIP_MEMORY_SCOPE_AGENT)) < wneed) { __builtin_amdgcn_s_sleep(2); if (++sp > (1u << 22)) break; }
            __builtin_amdgcn_fence(__ATOMIC_ACQUIRE, "agent");
            asm volatile("s_waitcnt vmcnt(0)" ::: "memory"); }
        asm volatile("" ::: "memory"); __builtin_amdgcn_s_barrier(); asm volatile("" ::: "memory");
    }
    __device__ __forceinline__ bool keep(const pg8::Unit&) const { return false; }
    __device__ __forceinline__ void epi(f32x4 (&acc)[2][2][4][2], const pg8::Unit& u, int wr, int wc, int fr, int fq) const {
        const int pn = u.pn, pm = u.pm;
        gptr wl = launder(ws);
        GAS bf16_t* KA = (GAS bf16_t*)(wl + WS_KA); GAS bf16_t* VA = (GAS bf16_t*)(wl + WS_VA); GAS bf16_t* KB = (GAS bf16_t*)(wl + WS_KB); GAS bf16_t* VB = (GAS bf16_t*)(wl + WS_VB);
        GAS bf16_t* QA = (GAS bf16_t*)(wl + WS_QA); GAS bf16_t* QB = (GAS bf16_t*)(wl + WS_QB); GAS bf16_t* SZA = (GAS bf16_t*)(wl + WS_SZA); GAS bf16_t* SZB = (GAS bf16_t*)(wl + WS_SZB);
        GAS bf16_t* SGA = (GAS bf16_t*)(wl + WS_SGA); GAS bf16_t* SGB = (GAS bf16_t*)(wl + WS_SGB);
        const GAS float* nwt = (const GAS float*)(wl + WS_NW) + layer * 256; const GAS float* qna = nwt; const GAS float* kna = nwt + 64; const GAS float* qnb = nwt + 128; const GAS float* knb = nwt + 192;
        const GAS float* rope = (const GAS float*)(wl + WS_ROPE);
        const bool ctxrow = pm >= 64;
        const int kv0 = ctxrow ? (pm - 64) * KVR : ((pm >> 4) * KVR + CTXL + (pm & 15) * 256);
        const int c0 = (fq & 1) + 4 * (fq >> 1);
        const int hcol = 64 * wc;
        int type; GAS bf16_t* dst; int pitch, rowbase; const GAS float* nw = nullptr; bool rope_on = false; float osc = 1.f;
        if (pn < 2)       { type = 1; dst = KA + pn * 256 + hcol; pitch = 512; rowbase = kv0; nw = kna; }
        else if (pn < 4)  { type = 0; dst = VA + (pn - 2) * 256 + hcol; pitch = 512; rowbase = kv0; }
        else if (pn == 4) { if (wc < 2) { type = 1; dst = KB + hcol; pitch = 128; rowbase = kv0; nw = knb; rope_on = !ctxrow; }
                            else        { type = 0; dst = VB + (hcol - 128); pitch = 128; rowbase = kv0; } }
        else if (pn < 7)  { type = 1; dst = QA + (pn - 5) * 256 + hcol; pitch = QP; rowbase = pm * 256; nw = qna; osc = C2; }
        else if (pn < 9)  { type = 1; dst = QB + (pn - 7) * 256 + hcol; pitch = QP; rowbase = pm * 256; nw = qnb; rope_on = !ctxrow; osc = C2; }
        else if (pn < 11) { type = 2; dst = SZA + (pn - 9) * 256 + hcol; pitch = QP; rowbase = pm * 256; }
        else if (pn < 13) { type = 2; dst = SZB + (pn - 11) * 256 + hcol; pitch = QP; rowbase = pm * 256; }
        else if (pn < 17) { type = 3; dst = SGA + (pn - 13) * 256 + hcol; pitch = DM; rowbase = pm * 256; }
        else              { type = 3; dst = SGB + (pn - 17) * 256 + hcol; pitch = DM; rowbase = pm * 256; }
        float w[2][8];
        if (type == 1) {
#pragma unroll
            for (int bj = 0; bj < 2; ++bj) { const f32x4 a = *(const GAS f32x4*)(nw + 8 * (c0 + 2 * bj)), b = *(const GAS f32x4*)(nw + 8 * (c0 + 2 * bj) + 4);
                w[bj][0] = a[0] * osc; w[bj][1] = a[1] * osc; w[bj][2] = a[2] * osc; w[bj][3] = a[3] * osc; w[bj][4] = b[0] * osc; w[bj][5] = b[1] * osc; w[bj][6] = b[2] * osc; w[bj][7] = b[3] * osc; }
        }
#pragma unroll
        for (int ai = 0; ai < 2; ++ai)
#pragma unroll
            for (int m = 0; m < 4; ++m) {
                const int rr = 128 * ai + 64 * wr + 16 * m + fr;
                float v[2][8];
#pragma unroll
                for (int bj = 0; bj < 2; ++bj)
#pragma unroll
                    for (int n = 0; n < 2; ++n)
#pragma unroll
                        for (int e = 0; e < 4; ++e) v[bj][4 * n + e] = acc[ai][bj][m][n][e];
                if (type == 1) {
                    float ss = 0.f;
#pragma unroll
                    for (int bj = 0; bj < 2; ++bj)
#pragma unroll
                        for (int i = 0; i < 8; ++i) ss += v[bj][i] * v[bj][i];
                    ss = sum_fq(ss);
                    const float rinv = __builtin_amdgcn_rsqf(ss * (1.0f / 64.0f) + EPS);
#pragma unroll
                    for (int bj = 0; bj < 2; ++bj)
#pragma unroll
                        for (int i = 0; i < 8; ++i) v[bj][i] = v[bj][i] * rinv * w[bj][i];
                    if (rope_on) {
                        const int t = (pm & 15) * 256 + rr;
                        const int pos = (fq >> 1) ? (t & 63) : (t >> 6);
                        const GAS float* tb = rope + (size_t)(pos * 16 + 8 * (fq & 1)) * 2;
#pragma unroll
                        for (int q4 = 0; q4 < 4; ++q4) { const f32x4 cs = *(const GAS f32x4*)(tb + 4 * q4);
                            { const int i = 2 * q4; const float x1 = v[0][i], x2 = v[1][i]; v[0][i] = x1 * cs[0] - x2 * cs[1]; v[1][i] = x2 * cs[0] + x1 * cs[1]; }
                            { const int i = 2 * q4 + 1; const float x1 = v[0][i], x2 = v[1][i]; v[0][i] = x1 * cs[2] - x2 * cs[3]; v[1][i] = x2 * cs[2] + x1 * cs[3]; } }
                    }
                } else if (type == 2) {
#pragma unroll
                    for (int bj = 0; bj < 2; ++bj)
#pragma unroll
                        for (int i = 0; i < 8; ++i) v[bj][i] = v[bj][i] * fsigmoid(v[bj][i]);
                } else if (type == 3) {
#pragma unroll
                    for (int bj = 0; bj < 2; ++bj)
#pragma unroll
                        for (int i = 0; i < 8; ++i) v[bj][i] = fsigmoid(v[bj][i]);
                }
                GAS bf16_t* rowp = dst + (size_t)(rowbase + rr) * pitch;
#pragma unroll
                for (int bj = 0; bj < 2; ++bj) { u32x4 o; o.x = cvtpk(v[bj][0], v[bj][1]); o.y = cvtpk(v[bj][2], v[bj][3]); o.z = cvtpk(v[bj][4], v[bj][5]); o.w = cvtpk(v[bj][6], v[bj][7]);
                    if (type >= 2) __builtin_nontemporal_store(o, (GAS u32x4*)(rowp + 8 * (c0 + 2 * bj))); else *(GAS u32x4*)(rowp + 8 * (c0 + 2 * bj)) = o; }
            }
    }
};

struct MergeProj {
    static constexpr int BHALF_ROWS = 128; static constexpr bool AFTER_DRAIN = false;
    __host__ __device__ static int brow(int R) { return (R & ~31) + pg8::perm32(R & 31); }
    unsigned char* ws; int layer;
    int G, c, single;
    __device__ __forceinline__ bool next(int i, pg8::Unit& u) const {
        u.sub = i & 1;
        if (single >= 0) { if (i >= 2) return false; u.pm = 64 + single / 4; u.pn = single % 4; return true; }
        const int L = (i >> 1) * G + c; if (L >= 64 * 4) return false;
        pg8::tile_of(L, 64, 4, u.pm, u.pn); return true;
    }
    __device__ __forceinline__ const char* aptr(const pg8::Unit& u) const {
        return u.pm >= 64 ? (const char*)(ws + (u.sub ? WS_YCB : WS_YCA)) + (size_t)(u.pm - 64) * 256 * 512 * 2 : (const char*)(ws + (u.sub ? WS_YB : WS_YA)) + (size_t)u.pm * 256 * 512 * 2; }
    __device__ __forceinline__ const char* bptr(const pg8::Unit& u) const { return (const char*)(ws + (u.sub ? WS_WOB : WS_WOA)) + ((size_t)layer * DM + (size_t)u.pn * 256) * 512 * 2; }
    __device__ __forceinline__ bool keep(const pg8::Unit& u) const { return u.sub == 0; }
    __device__ __forceinline__ void a_ready(const pg8::Unit&) const {}
    __device__ __forceinline__ void epi(f32x4 (&acc)[2][2][4][2], const pg8::Unit& u, int wr, int wc, int fr, int fq) const {
        const int row0 = u.pm * 256 + wr * 64 + fr, col0 = u.pn * 256 + wc * 32 + 8 * fq;
        gptr wl = launder(ws);
        const GAS bf16_t* SGA = (const GAS bf16_t*)(wl + WS_SGA); const GAS bf16_t* SGB = (const GAS bf16_t*)(wl + WS_SGB); GAS bf16_t* MG = (GAS bf16_t*)(wl + WS_MG);
#pragma unroll
        for (int ai = 0; ai < 2; ++ai) {
            u32x4 sbv[4][2], sav[4][2];
#pragma unroll
            for (int m = 0; m < 4; ++m)
#pragma unroll
                for (int bj = 0; bj < 2; ++bj) { const size_t off = (size_t)(row0 + ai * 128 + m * 16) * DM + col0 + bj * 128;
                    sbv[m][bj] = *(const GAS u32x4*)(SGB + off); if (u.sub == 0) sav[m][bj] = *(const GAS u32x4*)(SGA + off); }
#pragma unroll
            for (int m = 0; m < 4; ++m) {
                const size_t off = (size_t)(row0 + ai * 128 + m * 16) * DM + col0;
#pragma unroll
                for (int bj = 0; bj < 2; ++bj) {
                    const u32x4 sb = sbv[m][bj];
                    float b[8] = {bflo(sb.x), bfhi(sb.x), bflo(sb.y), bfhi(sb.y), bflo(sb.z), bfhi(sb.z), bflo(sb.w), bfhi(sb.w)};
#pragma unroll
                    for (int i = 0; i < 8; ++i) b[i] = fmaxf(b[i], 1e-30f);
                    if (u.sub == 0) {
                        const u32x4 sa = sav[m][bj];
                        const float a[8] = {bflo(sa.x), bfhi(sa.x), bflo(sa.y), bfhi(sa.y), bflo(sa.z), bfhi(sa.z), bflo(sa.w), bfhi(sa.w)};
#pragma unroll
                        for (int n = 0; n < 2; ++n)
#pragma unroll
                            for (int e = 0; e < 4; ++e) acc[ai][bj][m][n][e] *= a[4 * n + e] * __builtin_amdgcn_rcpf(b[4 * n + e]);
                    } else {
                        float o[8];
#pragma unroll
                        for (int n = 0; n < 2; ++n)
#pragma unroll
                            for (int e = 0; e < 4; ++e) o[4 * n + e] = acc[ai][bj][m][n][e] * b[4 * n + e];
                        u32x4 w; w.x = cvtpk(o[0], o[1]); w.y = cvtpk(o[2], o[3]); w.z = cvtpk(o[4], o[5]); w.w = cvtpk(o[6], o[7]);
                        if (u.pm >= 64) *(GAS u32x4*)((GAS bf16_t*)(wl + WS_MGC) + off - (size_t)ML * DM + bj * 128) = w;
                        else *(GAS u32x4*)(MG + off + bj * 128) = w;
                    }
                }
            }
            asm volatile("" ::: "memory");
        }
    }
};

#define OP_STG(LB, ai, m, bj, n) ((LB) + ((ai) * 128 + (m) * 16) * 512 + ((((2 * (n)) ^ (16 * ((bj) ^ ((m) & 1)))) << 4) ^ (L16)))
struct OutProj {
    static constexpr int BHALF_ROWS = 128; static constexpr bool AFTER_DRAIN = true;
    __host__ __device__ static int brow(int R) { return R; }
    unsigned char* ws; int layer; const GAS float* xin; GAS float* xout; const GAS float* cin;
    int G, c, single, fuse;
    int rmode;
    const GAS float* ng;
    __device__ __forceinline__ bool next(int i, pg8::Unit& u) const {
        u.sub = 0;
        if (single >= 0) { if (i != 0) return false; u.pm = 64 + single / 4; u.pn = single % 4; return true; }
        const int L = i * G + c; if (L >= 64 * 4 || i != 0) return false;
        pg8::tile_of(L, 64, 4, u.pm, u.pn); return true;
    }
    __device__ __forceinline__ const char* aptr(const pg8::Unit& u) const {
        return u.pm >= 64 ? (const char*)(ws + WS_MGC) + (size_t)(u.pm - 64) * 256 * DM * 2 : (const char*)(ws + WS_MG) + (size_t)u.pm * 256 * DM * 2; }
    __device__ __forceinline__ const char* bptr(const pg8::Unit& u) const { return (const char*)(ws + WS_WOUT) + ((size_t)layer * DM + (size_t)u.pn * 256) * DM * 2; }
    __device__ __forceinline__ void a_ready(const pg8::Unit&) const {}
    __device__ __forceinline__ bool keep(const pg8::Unit&) const { return false; }
    __device__ __forceinline__ void epi_drain(f32x4 (&acc)[2][2][4][2], const pg8::Unit& u, int wr, int wc, int fr, int fq, LAS unsigned char* lds, int wid, int lane) const {
        const bool ctxrow = u.pm >= 64;
        gptr wl = launder(ws);
        GAS float* cout = (GAS float*)(wl + WS_CTXN); const GAS float* mod = (const GAS float*)(wl + WS_MOD) + (size_t)layer * 5 * 3072;
        const GAS float* src = ctxrow ? cin + (size_t)(u.pm - 64) * 256 * DM : xin + (size_t)u.pm * 256 * DM;
        GAS float* dstp = ctxrow ? cout + (size_t)(u.pm - 64) * 256 * DM : xout + (size_t)u.pm * 256 * DM;
        const GAS float* gate = mod + (ctxrow ? 4 : (u.pm >> 4)) * 3072 + 2048;
        const int col0 = u.pn * 256 + wc * 32 + 4 * fq;
        {
            f32x4 gv[2][2];
#pragma unroll
            for (int bj = 0; bj < 2; ++bj)
#pragma unroll
                for (int n = 0; n < 2; ++n) gv[bj][n] = *(const GAS f32x4*)(gate + col0 + bj * 128 + n * 16);
            GAS bf16_t* x16 = (GAS bf16_t*)xout + (size_t)u.pm * 256 * 2048 + u.pn * 512 + wc * 32 + 4 * fq;
            if (rmode == 2) {
                int fr_ = fr; asm volatile("" : "+v"(fr_)); const int fr = fr_;
                { const GAS unsigned char* tsrc = (const GAS unsigned char*)xout + ((size_t)u.pm * 256 * 4096 + (size_t)u.pn * 1024);
#pragma unroll
                  for (int j = 0; j < 16; ++j) { const int r = 2 * (wid * 16 + j) + (lane >> 5), c = ((lane & 31) ^ r) & 31;
                      __builtin_amdgcn_global_load_lds((const GAS unsigned*)(tsrc + (size_t)r * 4096 + c * 16), (LAS unsigned*)(lds + (wid * 16 + j) * 1024), 16, 0, 0); } }
                asm volatile("s_waitcnt vmcnt(0)" ::: "memory"); __builtin_amdgcn_s_barrier(); asm volatile("" ::: "memory");
                const int L16 = (((4 * wc + (fq >> 1)) ^ fr) << 4); LAS unsigned char* LB = lds + (wr * 64 + fr) * 512 + 8 * (fq & 1);
#pragma unroll
                for (int ai = 0; ai < 2; ++ai)
#pragma unroll
                    for (int m = 0; m < 4; ++m) { const int rr = ai * 128 + wr * 64 + m * 16 + fr; const size_t off = (size_t)rr * DM + col0;
#pragma unroll
                        for (int bj = 0; bj < 2; ++bj)
#pragma unroll
                            for (int n = 0; n < 2; ++n) {
                                const unsigned long long xr = *(const LAS unsigned long long*)OP_STG(LB, ai, m, bj, n);
                                const unsigned lo = (unsigned)xr, hi = (unsigned)(xr >> 32);
                                const f32x4 xv = {bflo(lo), bfhi(lo), bflo(hi), bfhi(hi)};
                                __builtin_nontemporal_store(xv + gv[bj][n] * acc[ai][bj][m][n], (GAS f32x4*)(dstp + off + bj * 128 + n * 16)); } }
                return;
            } else if (rmode == 1) {
            int fr_ = fr; asm volatile("" : "+v"(fr_)); const int fr = fr_;
            int L16 = (((4 * wc + (fq >> 1)) ^ fr) << 4); LAS unsigned char* LB = lds + (wr * 64 + fr) * 512 + 8 * (fq & 1);
#pragma unroll
            for (int ai = 0; ai < 2; ++ai)
#pragma unroll
                for (int mh = 0; mh < 2; ++mh) {
                    f32x4 xs[2][2][2];
#pragma unroll
                    for (int m2 = 0; m2 < 2; ++m2) { const size_t off = (size_t)(ai * 128 + wr * 64 + (2 * mh + m2) * 16 + fr) * DM + col0;
#pragma unroll
                        for (int bj = 0; bj < 2; ++bj)
#pragma unroll
                            for (int n = 0; n < 2; ++n) xs[m2][bj][n] = *(const GAS f32x4*)(src + off + bj * 128 + n * 16); }
#pragma unroll
                    for (int m2 = 0; m2 < 2; ++m2) { const int m = 2 * mh + m2; float sq = 0.f;
#pragma unroll
                        for (int bj = 0; bj < 2; ++bj)
#pragma unroll
                            for (int n = 0; n < 2; ++n) { const f32x4 y = xs[m2][bj][n] + gv[bj][n] * acc[ai][bj][m][n];
                                sq += (y[0] * y[0] + y[1] * y[1]) + (y[2] * y[2] + y[3] * y[3]);
                                *(LAS unsigned long long*)OP_STG(LB, ai, m, bj, n) =
                                    (unsigned long long)cvtpk(y[0], y[1]) | ((unsigned long long)cvtpk(y[2], y[3]) << 32); }
                        sq = sum_fq(sq);
                        if (fq == 0) ((LAS float*)(lds + PP_OFF))[(ai * 128 + wr * 64 + m * 16 + fr) * 4 + wc] = sq; }
                    asm volatile("" ::: "memory");
                }
            asm volatile("s_waitcnt lgkmcnt(0)" ::: "memory"); __builtin_amdgcn_s_barrier(); asm volatile("" ::: "memory");
            const int row = wid * 32 + (lane & 31);
            GAS float* xb = (GAS float*)(wl + WS_XB) + ((size_t)u.pm * 256 + row) * 4;
            unsigned* pc = (unsigned*)(ws + WS_CTL) + CW_CNT + 64 * (16 + u.pm);
            { LAS float* Pp = (LAS float*)(lds + PP_OFF);
              if (lane < 32) { const float t4 = (Pp[row * 4 + 0] + Pp[row * 4 + 1]) + (Pp[row * 4 + 2] + Pp[row * 4 + 3]);
                  __hip_atomic_store(xb + u.pn, t4, __ATOMIC_RELAXED, __HIP_MEMORY_SCOPE_AGENT); } }
            asm volatile("s_waitcnt vmcnt(0)" ::: "memory");
            if (lane == 0) __hip_atomic_fetch_add(pc, 1u, __ATOMIC_RELAXED, __HIP_MEMORY_SCOPE_AGENT);
            { GAS unsigned char* tdst = (GAS unsigned char*)xout + ((size_t)u.pm * 256 * 4096 + (size_t)u.pn * 1024);
#pragma unroll
              for (int j = 0; j < 16; ++j) { const int r = 2 * (wid * 16 + j) + (lane >> 5), c = ((lane & 31) ^ r) & 31;
                  __builtin_nontemporal_store(*(const LAS u32x4*)(lds + (wid * 16 + j) * 1024 + lane * 16), (GAS u32x4*)(tdst + (size_t)r * 4096 + c * 16));
                  if ((j & 3) == 3) asm volatile("" ::: "memory"); } }
            const GAS float* md = (const GAS float*)(wl + WS_MOD) + (size_t)((layer + 1) * 5 + (u.pm >> 4)) * 3072;
            f32x4 gs[2][2], sh[2][2];
#pragma unroll
            for (int bj = 0; bj < 2; ++bj)
#pragma unroll
                for (int n = 0; n < 2; ++n) { const int cc = col0 + bj * 128 + n * 16; gs[bj][n] = *(const GAS f32x4*)(ng + cc) * (*(const GAS f32x4*)(md + 1024 + cc) + 1.0f); }
            asm volatile("" ::: "memory");
#pragma unroll
            for (int bj = 0; bj < 2; ++bj)
#pragma unroll
                for (int n = 0; n < 2; ++n) sh[bj][n] = *(const GAS f32x4*)(md + col0 + bj * 128 + n * 16);
            if (wid == 0) { unsigned sp = 0;
                while ((unsigned)__builtin_amdgcn_readfirstlane(__hip_atomic_load(pc, __ATOMIC_RELAXED, __HIP_MEMORY_SCOPE_AGENT)) < 32u) { __builtin_amdgcn_s_sleep(2); if (++sp > (1u << 22)) break; }
                __builtin_amdgcn_fence(__ATOMIC_ACQUIRE, "agent"); }
            asm volatile("s_waitcnt lgkmcnt(0)" ::: "memory"); __builtin_amdgcn_s_barrier(); asm volatile("" ::: "memory");
            LAS float* Sr = (LAS float*)(lds + PP_OFF + 4096);
            if (lane < 32) { float tot = 0.f;
#pragma unroll
                for (int t = 0; t < 4; ++t) tot += __hip_atomic_load(xb + t, __ATOMIC_RELAXED, __HIP_MEMORY_SCOPE_AGENT);
                Sr[row] = __builtin_amdgcn_rsqf(tot * (1.0f / DM) + EPS); }
            asm volatile("s_waitcnt vmcnt(0) lgkmcnt(0)" ::: "memory"); __builtin_amdgcn_s_barrier(); asm volatile("" ::: "memory");
            asm volatile("" : "+v"(L16));
#pragma unroll
            for (int ai = 0; ai < 2; ++ai)
#pragma unroll
                for (int m = 0; m < 4; ++m) { const int rr = ai * 128 + wr * 64 + m * 16 + fr; const float r = Sr[rr];
#pragma unroll
                    for (int bj = 0; bj < 2; ++bj)
#pragma unroll
                        for (int n = 0; n < 2; ++n) { LAS unsigned long long* sp = (LAS unsigned long long*)OP_STG(LB, ai, m, bj, n);
                            const unsigned long long xr = *sp; const unsigned lo = (unsigned)xr, hi = (unsigned)(xr >> 32);
                            const f32x4 xv = {bflo(lo), bfhi(lo), bflo(hi), bfhi(hi)};
                            const f32x4 y = xv * r * gs[bj][n] + sh[bj][n];
                            *sp = (unsigned long long)cvtpk(y[0], y[1]) | ((unsigned long long)cvtpk(y[2], y[3]) << 32); } }
            asm volatile("s_waitcnt lgkmcnt(0)" ::: "memory"); __builtin_amdgcn_s_barrier(); asm volatile("" ::: "memory");
            { GAS unsigned char* hdst = (GAS unsigned char*)(wl + WS_HX) + ((size_t)u.pm * 256 * 2048 + (size_t)u.pn * 512);
#pragma unroll
              for (int j = 0; j < 16; ++j) { const int r = 2 * (wid * 16 + j) + (lane >> 5), c = ((lane & 31) ^ r) & 31;
                  *(GAS u32x4*)(hdst + (size_t)r * 2048 + c * 16) = *(const LAS u32x4*)(lds + (wid * 16 + j) * 1024 + lane * 16);
                  if ((j & 3) == 3) asm volatile("" ::: "memory"); } }
            return;
            } else {
            int fr_ = fr; asm volatile("" : "+v"(fr_)); const int fr = fr_;
#pragma unroll
            for (int ai = 0; ai < 2; ++ai) {
                f32x4 xs[4][2][2];
#pragma unroll
                for (int m = 0; m < 4; ++m) { const size_t off = (size_t)(ai * 128 + wr * 64 + m * 16 + fr) * DM + col0;
#pragma unroll
                    for (int bj = 0; bj < 2; ++bj)
#pragma unroll
                        for (int n = 0; n < 2; ++n) xs[m][bj][n] = *(const GAS f32x4*)(src + off + bj * 128 + n * 16); }
#pragma unroll
                for (int m = 0; m < 4; ++m) { const size_t off = (size_t)(ai * 128 + wr * 64 + m * 16 + fr) * DM + col0;
#pragma unroll
                    for (int bj = 0; bj < 2; ++bj)
#pragma unroll
                        for (int n = 0; n < 2; ++n) *(GAS f32x4*)(dstp + off + bj * 128 + n * 16) = xs[m][bj][n] + gv[bj][n] * acc[ai][bj][m][n]; }
                asm volatile("" ::: "memory");
            }
            return;
            }
        }
    }
};

namespace attn_body {
constexpr int NW = 8, QBLK = 32, KVBLK = 64;
__device__ __forceinline__ int crow(int r, int hi) { return (r & 3) + 8 * (r >> 2) + 4 * hi; }
#define SBAR() __builtin_amdgcn_sched_barrier(0)
constexpr int NSLOT = 3, SLOTB = 8192;
constexpr int LDS_K = 0, LDS_V = NSLOT * SLOTB, LDS_WS = 2 * NSLOT * SLOTB, LDS_OST = LDS_WS + NW * 64 * 4, LDS_TAB = LDS_OST + NW * 4096, LDS_BYTES_A = LDS_TAB + 4096;
constexpr int TABM = 64, ZOFF = 640;
__device__ __forceinline__ void glds16(const GAS void* gsrc, unsigned lds_dst) { unsigned keep;
    asm volatile("s_mov_b32 %0, m0\n\ts_mov_b32 m0, %2\n\ts_nop 0\n\tglobal_load_lds_dwordx4 %1, off\n\ts_mov_b32 m0, %0" : "=&s"(keep) : "v"(gsrc), "s"(lds_dst) : "memory"); }
__device__ __forceinline__ float max3f(float a, float b, float c) { float r; asm("v_max3_f32 %0, %1, %2, %3" : "=v"(r) : "v"(a), "v"(b), "v"(c)); return r; }
__device__ __forceinline__ float max2f(float a, float b) { float r; asm("v_max_f32_e32 %0, %1, %2" : "=v"(r) : "v"(a), "v"(b)); return r; }
__device__ __forceinline__ float fadd_s(float a, float b) { float r; asm("v_add_f32_e32 %0, %1, %2" : "=v"(r) : "v"(a), "v"(b)); return r; }
__device__ __forceinline__ float fsub_s(float a, float b) { float r; asm("v_sub_f32_e32 %0, %1, %2" : "=v"(r) : "v"(a), "v"(b)); return r; }
#define WAIT_BAR(N) asm volatile("s_waitcnt vmcnt(" #N ") lgkmcnt(0)\n\ts_barrier" ::: "memory")

__device__ __forceinline__ void qkt(f32x16& p0, f32x16& p1, const char* Kslot, const bf16x8* qr, const f32x16& negm, int r32, int hi) {
    const char* kb = Kslot + hi * 1024 + r32 * 16;
#pragma unroll
    for (int d0 = 0; d0 < 4; ++d0) {
        const bf16x8 b0 = *reinterpret_cast<const bf16x8*>(kb + d0 * 2048);
        const bf16x8 b1 = *reinterpret_cast<const bf16x8*>(kb + d0 * 2048 + 512);
        if (d0 == 0) { p0 = __builtin_amdgcn_mfma_f32_32x32x16_bf16(b0, qr[0], negm, 0, 0, 0); p1 = __builtin_amdgcn_mfma_f32_32x32x16_bf16(b1, qr[0], negm, 0, 0, 0); }
        else { p0 = __builtin_amdgcn_mfma_f32_32x32x16_bf16(b0, qr[d0], p0, 0, 0, 0); p1 = __builtin_amdgcn_mfma_f32_32x32x16_bf16(b1, qr[d0], p1, 0, 0, 0); } }
}
typedef LAS const char* lds_cptr;
typedef short v4i16_t __attribute__((ext_vector_type(4)));
__device__ __forceinline__ void kload8(bf16x8* kf, lds_cptr kp) {
    kf[0] = *(const LAS bf16x8*)(kp);        kf[1] = *(const LAS bf16x8*)(kp + 512);
    kf[2] = *(const LAS bf16x8*)(kp + 2048); kf[3] = *(const LAS bf16x8*)(kp + 2560);
    kf[4] = *(const LAS bf16x8*)(kp + 4096); kf[5] = *(const LAS bf16x8*)(kp + 4608);
    kf[6] = *(const LAS bf16x8*)(kp + 6144); kf[7] = *(const LAS bf16x8*)(kp + 6656);
}
__device__ __forceinline__ void kload2(bf16x8* kf, lds_cptr kp, int j) { kf[2 * j] = *(const LAS bf16x8*)(kp + j * 2048); kf[2 * j + 1] = *(const LAS bf16x8*)(kp + j * 2048 + 512); }
__device__ __forceinline__ s16x4 vtr(lds_cptr p) { return __builtin_bit_cast(s16x4, __builtin_amdgcn_ds_read_tr16_b64_v4i16((LAS v4i16_t*)p)); }
__device__ __forceinline__ float rowmax(const f32x16& p0, const f32x16& p1) {
    float a = max3f(p0[0], p0[1], p1[0]), b = max3f(p0[2], p0[3], p1[1]); a = max3f(a, p1[2], p1[3]);
#pragma unroll
    for (int r = 4; r < 16; r += 4) { a = max3f(a, p0[r], p0[r + 1]); b = max3f(b, p0[r + 2], p0[r + 3]); a = max3f(a, p1[r], p1[r + 1]); b = max3f(b, p1[r + 2], p1[r + 3]); }
    const float m = max2f(a, b);
    auto rr = __builtin_amdgcn_permlane32_swap(__float_as_uint(m), __float_as_uint(m), false, false);
    return max2f(__uint_as_float(rr[0]), __uint_as_float(rr[1]));
}
__device__ __forceinline__ void pv(f32x16* o, int vb, bf16x8 pa0, bf16x8 pa1, bf16x8 pa2, bf16x8 pa3) {
#pragma unroll
    for (int d0 = 0; d0 < 2; ++d0) { s16x4 lo[4], hi[4];
#pragma unroll
        for (int ks = 0; ks < 4; ++ks) {
            asm volatile("ds_read_b64_tr_b16 %0,%1 offset:%c2" : "=&v"(lo[ks]) : "v"(vb), "i"(d0 * 4096 + ks * 1024) : "memory");
            asm volatile("ds_read_b64_tr_b16 %0,%1 offset:%c2" : "=&v"(hi[ks]) : "v"(vb), "i"(d0 * 4096 + ks * 1024 + 512) : "memory"); }
        asm volatile("s_waitcnt lgkmcnt(0)" ::: "memory"); SBAR();
#define PK(k) (bf16x8){lo[k][0], lo[k][1], lo[k][2], lo[k][3], hi[k][0], hi[k][1], hi[k][2], hi[k][3]}
        o[d0] = __builtin_amdgcn_mfma_f32_32x32x16_bf16(pa0, PK(0), o[d0], 0, 0, 0);
        o[d0] = __builtin_amdgcn_mfma_f32_32x32x16_bf16(pa1, PK(1), o[d0], 0, 0, 0);
        o[d0] = __builtin_amdgcn_mfma_f32_32x32x16_bf16(pa2, PK(2), o[d0], 0, 0, 0);
        o[d0] = __builtin_amdgcn_mfma_f32_32x32x16_bf16(pa3, PK(3), o[d0], 0, 0, 0);
#undef PK
    }
}

template <int MODE, int KP>
__device__ __forceinline__ void attn_unit(const GAS bf16_t* Qw0, const GAS bf16_t* Kh, const GAS bf16_t* Vh, const int NT, const int lo,
                                          GAS bf16_t* Ow0, const GAS bf16_t* Zw0, const int qr0, const GAS float* rpbh, char* shm) {
    int tid_ = threadIdx.x; asm volatile("" : "+v"(tid_));
    const int tid = tid_, lane = tid & 63, r32 = lane & 31, hi = lane >> 5; const int wid = __builtin_amdgcn_readfirstlane(tid >> 6);
    const GAS bf16_t* Qw = Qw0 + (long)(wid * QBLK) * QP;
    const unsigned lds0 = (unsigned)(uintptr_t)shm;
    float* wsf = (float*)(shm + LDS_WS) + wid * 64;
    const GAS bf16_t* ksrc = Kh + (long)lane * KP + wid * 8;
    const GAS bf16_t* vsrc = Vh + (long)(16 * (wid & 3) + (lane >> 2)) * KP + (wid >> 2) * 32 + (lane & 3) * 8;
    const unsigned kdst = lds0 + LDS_K + wid * 1024, vdst = lds0 + LDS_V + wid * 1024;
#define TMAP(t) ((MODE == 1 && (t) >= 4) ? (t) + lo : (t))
#define DMA_K(t, slot) glds16(ksrc + (long)TMAP(t) * KVBLK * KP, (unsigned)__builtin_amdgcn_readfirstlane(kdst + (slot)))
#define DMA_V(t, slot) glds16(vsrc + (long)TMAP(t) * KVBLK * KP, (unsigned)__builtin_amdgcn_readfirstlane(vdst + (slot)))
    const int vb0 = (int)(lds0 + LDS_V) + ((lane >> 4) & 1) * 32 + (lane & 3) * 8 + (4 * hi + ((lane & 15) >> 2)) * 64;
    const char* Kbase = shm + LDS_K; bf16x8 kf[8];
    const lds_cptr shm3 = (lds_cptr)shm; const lds_cptr kp0 = shm3 + LDS_K + hi * 1024 + r32 * 16; const lds_cptr vp0 = shm3 + LDS_V + ((lane >> 4) & 1) * 32 + (lane & 3) * 8 + (4 * hi + ((lane & 15) >> 2)) * 64;
    DMA_K(0, 0); DMA_V(0, 0); DMA_K(1, SLOTB);
    bf16x8 qr[4];
#pragma unroll
    for (int d0 = 0; d0 < 4; ++d0) qr[d0] = *(const GAS bf16x8*)(Qw + (long)r32 * QP + d0 * 16 + hi * 8);
    int na_qr = 0, na_rs = 0; const LAS float* na_tb = nullptr; const LAS float* na_tm = nullptr;
    if (MODE == 1) {
        LAS float* tab = (LAS float*)(shm3 + LDS_TAB);
        for (int i = tid; i < ZOFF + 128; i += NW * 64) { float v = 0.f;
            if (i >= ZOFF) v = (i - ZOFF >= 48 && i - ZOFF < 64) ? 0.f : -INFINITY;
            else if (i >= TABM && i < TABM + 15 * 32) { const int dr = (i - TABM) >> 5, dc = (i - TABM) & 31; if (dc < 31) v = rpbh[dr * 31 + dc] * LOG2E; }
            tab[i] = v; }
        na_qr = qr0 + (wid >> 1);
        na_rs = na_qr - 4; na_rs = na_rs < 0 ? 0 : (na_rs > 56 ? 56 : na_rs);
        const int qc = 32 * (wid & 1) + r32; int cs = qc - 8; cs = cs < 0 ? 0 : (cs > 48 ? 48 : cs);
        na_tb = (const LAS float*)(shm3 + LDS_TAB) + TABM + (4 * hi - qc + 15);
        na_tm = (const LAS float*)(shm3 + LDS_TAB) + ZOFF + (4 * hi - cs + 48);
    }
    float l_reg = 0.f; f32x16 o[2]; o[0] = f32x16{}; o[1] = f32x16{}; const f32x16 zc = f32x16{};
#define CMASK(P0, P1, t) do { if (MODE == 1 && (t) >= 4) { const float NEG_ = -INFINITY; const int kr_ = lo + (t) - 4; \
        if ((unsigned)(kr_ - na_rs) < 8u) { const LAS float* tb_ = na_tb + (kr_ - na_qr + 7) * 32; const LAS float* tm_ = na_tm; asm volatile("" : "+v"(tm_)); \
            _Pragma("unroll") for (int g_ = 0; g_ < 4; ++g_) { \
              _Pragma("unroll") for (int r = 4 * g_; r < 4 * g_ + 4; ++r) { const int kc_ = (r & 3) + 8 * (r >> 2); \
                P0[r] += tb_[kc_] + tm_[kc_]; P1[r] += tb_[kc_ + 32] + tm_[kc_ + 32]; } \
              asm volatile("" : "+v"(P0), "+v"(P1)); SBAR(); } } \
        else { _Pragma("unroll") for (int r = 0; r < 16; ++r) { P0[r] = NEG_; P1[r] = NEG_; } } } } while (0)
    f32x16 pA0, pA1, pB0, pB1;
    int sl_prev = 0, sl_cur = 0, sl_next = SLOTB;
#define ROT() do { sl_prev = sl_cur; sl_cur = sl_next; sl_next = (sl_next == (NSLOT - 1) * SLOTB) ? 0 : sl_next + SLOTB; } while (0)
    DMA_K(2, 2 * SLOTB);
    WAIT_BAR(3);
    qkt(pA0, pA1, Kbase, qr, zc, r32, hi); asm volatile("s_nop 15\n\ts_nop 7" : "+v"(pA0), "+v"(pA1));
    _Pragma("unroll") for (int r = 0; r < 16; ++r) pA0[r] = __builtin_amdgcn_exp2f(pA0[r]);
    _Pragma("unroll") for (int r = 0; r < 16; ++r) pA1[r] = __builtin_amdgcn_exp2f(pA1[r]);
    WAIT_BAR(0);
    DMA_K(3, 0); DMA_V(1, SLOTB);
    ROT();
    kload8(kf, kp0 + sl_cur);
    WAIT_BAR(2);
    s16x4 vlo[8], vhi[8]; u32x4 pw0, pw1, pw2, pw3;
#define PKW(P, B) cvtpk(P[B], P[B + 1])
#define PAF(k) __builtin_bit_cast(bf16x8, pw##k)
#define VFR(i) (bf16x8){vlo[i][0], vlo[i][1], vlo[i][2], vlo[i][3], vhi[i][0], vhi[i][1], vhi[i][2], vhi[i][3]}
#define PIN(x) asm volatile("" : "+v"(x))
#define GAPA(MF, A0, A1, A2, A3, W0, W1, PW) do { __builtin_amdgcn_s_setprio(1); MF; __builtin_amdgcn_s_setprio(0); sacc += A0; sacc += A1; sacc += A2; sacc += A3; PIN(sacc); W0; W1; PIN(PW); SBAR(); } while (0)
#define EX(v) __builtin_amdgcn_exp2f(v)
#define GAPB(MF, X, B) do { __builtin_amdgcn_s_setprio(1); MF; __builtin_amdgcn_s_setprio(0); X[B] = EX(X[B]); X[B + 1] = EX(X[B + 1]); X[B + 2] = EX(X[B + 2]); X[B + 3] = EX(X[B + 3]); PIN(X); SBAR(); } while (0)
#define VRD(i) do { vlo[i] = vtr(vp_ + (((i) >> 2) * 4096 + ((i) & 3) * 1024)); vhi[i] = vtr(vp_ + (((i) >> 2) * 4096 + ((i) & 3) * 1024 + 512)); } while (0)
#define KRD(G, j) do { if (G) { kload2(kf, kp0 + sl_next, j); SBAR(); } } while (0)
#define STEP(C0, C1, P0, P1, t, GK, GV, GL) do { SBAR(); \
    const lds_cptr vp_ = vp0 + sl_prev; \
    VRD(0); SBAR(); float sacc = (P0[0] + P0[1]); \
    GAPA(C0 = __builtin_amdgcn_mfma_f32_32x32x16_bf16(kf[0], qr[0], zc, 0, 0, 0), P0[2], P0[3], P0[4], P0[5],     pw0[0] = PKW(P0, 0), pw0[1] = PKW(P0, 2), pw0); \
    VRD(4); SBAR(); GAPA(C1 = __builtin_amdgcn_mfma_f32_32x32x16_bf16(kf[1], qr[0], zc, 0, 0, 0), P0[6], P0[7], P0[8], P0[9],     pw0[2] = PKW(P0, 4), pw0[3] = PKW(P0, 6), pw0); \
    VRD(1); SBAR(); GAPA(C0 = __builtin_amdgcn_mfma_f32_32x32x16_bf16(kf[2], qr[1], C0, 0, 0, 0),   P0[10], P0[11], P0[12], P0[13], pw1[0] = PKW(P0, 8), pw1[1] = PKW(P0, 10), pw1); \
    VRD(5); SBAR(); GAPA(C1 = __builtin_amdgcn_mfma_f32_32x32x16_bf16(kf[3], qr[1], C1, 0, 0, 0),   P0[14], P0[15], P1[0], P1[1],   pw1[2] = PKW(P0, 12), pw1[3] = PKW(P0, 14), pw1); \
    VRD(2); SBAR(); GAPA(C0 = __builtin_amdgcn_mfma_f32_32x32x16_bf16(kf[4], qr[2], C0, 0, 0, 0),   P1[2], P1[3], P1[4], P1[5],     pw2[0] = PKW(P1, 0), pw2[1] = PKW(P1, 2), pw2); \
    VRD(6); SBAR(); GAPA(C1 = __builtin_amdgcn_mfma_f32_32x32x16_bf16(kf[5], qr[2], C1, 0, 0, 0),   P1[6], P1[7], P1[8], P1[9],     pw2[2] = PKW(P1, 4), pw2[3] = PKW(P1, 6), pw2); \
    VRD(3); SBAR(); GAPA(C0 = __builtin_amdgcn_mfma_f32_32x32x16_bf16(kf[6], qr[3], C0, 0, 0, 0),   P1[10], P1[11], P1[12], P1[13], pw3[0] = PKW(P1, 8), pw3[1] = PKW(P1, 10), pw3); \
    VRD(7); SBAR(); GAPA(C1 = __builtin_amdgcn_mfma_f32_32x32x16_bf16(kf[7], qr[3], C1, 0, 0, 0),   P1[14], P1[15], 0.f, 0.f,       pw3[2] = PKW(P1, 12), pw3[3] = PKW(P1, 14), pw3); \
    l_reg += sacc; \
    if (GK) { DMA_K((t) + 3, sl_cur); } if (GV) { DMA_V((t) + 1, sl_next); } \
    CMASK(C0, C1, t); \
    SBAR(); \
    GAPB(o[0] = __builtin_amdgcn_mfma_f32_32x32x16_bf16(PAF(0), VFR(0), o[0], 0, 0, 0), C0, 0); \
    GAPB(o[1] = __builtin_amdgcn_mfma_f32_32x32x16_bf16(PAF(0), VFR(4), o[1], 0, 0, 0), C0, 4); \
    KRD(GL, 0); GAPB(o[0] = __builtin_amdgcn_mfma_f32_32x32x16_bf16(PAF(1), VFR(1), o[0], 0, 0, 0), C0, 8); \
    KRD(GL, 1); GAPB(o[1] = __builtin_amdgcn_mfma_f32_32x32x16_bf16(PAF(1), VFR(5), o[1], 0, 0, 0), C0, 12); \
    KRD(GL, 2); GAPB(o[0] = __builtin_amdgcn_mfma_f32_32x32x16_bf16(PAF(2), VFR(2), o[0], 0, 0, 0), C1, 0); \
    KRD(GL, 3); GAPB(o[1] = __builtin_amdgcn_mfma_f32_32x32x16_bf16(PAF(2), VFR(6), o[1], 0, 0, 0), C1, 4); \
    GAPB(o[0] = __builtin_amdgcn_mfma_f32_32x32x16_bf16(PAF(3), VFR(3), o[0], 0, 0, 0), C1, 8); \
    GAPB(o[1] = __builtin_amdgcn_mfma_f32_32x32x16_bf16(PAF(3), VFR(7), o[1], 0, 0, 0), C1, 12); \
    } while (0)
    int t = 1;
    for (; t + 5 < NT; t += 2) {
        STEP(pB0, pB1, pA0, pA1, t, true, true, true);     WAIT_BAR(2); ROT();
        STEP(pA0, pA1, pB0, pB1, t + 1, true, true, true); WAIT_BAR(2); ROT();
    }
#define ENDW(tt) do { if ((tt) + 3 < NT) { WAIT_BAR(2); } else if ((tt) + 2 < NT) { WAIT_BAR(1); } else { WAIT_BAR(0); } } while (0)
    for (; t + 1 < NT; t += 2) {
        STEP(pB0, pB1, pA0, pA1, t, (t + 3 < NT), (t + 1 < NT), (t + 1 < NT));         ENDW(t);     ROT();
        STEP(pA0, pA1, pB0, pB1, t + 1, (t + 4 < NT), (t + 2 < NT), (t + 2 < NT));     ENDW(t + 1); ROT();
    }
#define DRAIN(PX0, PX1, SLOT) do { float sacc = PX0[0] + PX0[1]; _Pragma("unroll") for (int r = 2; r < 16; ++r) sacc += PX0[r]; _Pragma("unroll") for (int r = 0; r < 16; ++r) sacc += PX1[r]; l_reg += sacc; \
      pw0 = (u32x4){PKW(PX0, 0), PKW(PX0, 2), PKW(PX0, 4), PKW(PX0, 6)}; pw1 = (u32x4){PKW(PX0, 8), PKW(PX0, 10), PKW(PX0, 12), PKW(PX0, 14)}; pw2 = (u32x4){PKW(PX1, 0), PKW(PX1, 2), PKW(PX1, 4), PKW(PX1, 6)}; pw3 = (u32x4){PKW(PX1, 8), PKW(PX1, 10), PKW(PX1, 12), PKW(PX1, 14)}; \
      SBAR(); pv(o, vb0 + (SLOT), PAF(0), PAF(1), PAF(2), PAF(3)); } while (0)
    if (t < NT) { STEP(pB0, pB1, pA0, pA1, NT - 1, false, false, false); DRAIN(pB0, pB1, sl_cur); }
    else { DRAIN(pA0, pA1, sl_prev); }
#undef DRAIN
#undef PKW
#undef PAF
#undef VFR
#undef PIN
#undef GAPA
#undef GAPB
#undef EX
#undef VRD
#undef KRD
#undef STEP
#undef ENDW
    { auto rr = __builtin_amdgcn_permlane32_swap(__float_as_uint(l_reg), __float_as_uint(l_reg), false, false); l_reg = __uint_as_float(rr[0]) + __uint_as_float(rr[1]); }
    if (hi == 0) wsf[32 + r32] = l_reg; asm volatile("s_waitcnt lgkmcnt(0)" ::: "memory");
    float rli[16];
#pragma unroll
    for (int r = 0; r < 16; ++r) rli[r] = __builtin_amdgcn_rcpf(wsf[32 + crow(r, hi)]);
    GAS bf16_t* Ow = Ow0 + (long)(wid * QBLK) * QP; const GAS bf16_t* Zw = Zw0 + (long)(wid * QBLK) * QP;
    { __hip_bfloat16* stg = (__hip_bfloat16*)(shm + LDS_OST) + wid * 2048;
#pragma unroll
      for (int r = 0; r < 16; ++r) { const int orow = crow(r, hi);
#pragma unroll
        for (int d0 = 0; d0 < 2; ++d0) stg[orow * 64 + d0 * 32 + r32] = __float2bfloat16(o[d0][r] * rli[r]); }
      asm volatile("s_waitcnt lgkmcnt(0)" ::: "memory");
#pragma unroll
      for (int i = 0; i < 4; ++i) { const int row = i * 8 + (lane >> 3), ch = lane & 7; const u32x4 v = *(const u32x4*)(stg + row * 64 + ch * 8);
        const u32x4 z = *(const GAS u32x4*)(Zw + (long)row * QP + ch * 8); u32x4 y;
        y.x = cvtpk(bflo(v.x) * bflo(z.x), bfhi(v.x) * bfhi(z.x)); y.y = cvtpk(bflo(v.y) * bflo(z.y), bfhi(v.y) * bfhi(z.y));
        y.z = cvtpk(bflo(v.z) * bflo(z.z), bfhi(v.z) * bfhi(z.z)); y.w = cvtpk(bflo(v.w) * bflo(z.w), bfhi(v.w) * bfhi(z.w));
        *(GAS u32x4*)(Ow + (long)row * QP + ch * 8) = y; } }
    asm volatile("s_waitcnt lgkmcnt(0)\n\ts_barrier" ::: "memory");
#undef DMA_K
#undef DMA_V
#undef TMAP
#undef CMASK
#undef ROT
}
#undef SBAR
#undef WAIT_BAR
}

#define XB_TMO      128
#define XB_XCNT(j)  (256  + 64 * (j))
#define XB_XSUB(j)  (1280 + 64 * (j))
#define XB_XGEN(j)  (2304 + 64 * (j))
#define XB_TOP      3328
#define XB_TOPGEN   3392
#define XCD_BAR_WORDS 3456
#define XB_SPIN_CAP (1u << 18)
__device__ __forceinline__ unsigned xb_ld(unsigned* p)              { return __hip_atomic_load(p, __ATOMIC_RELAXED, __HIP_MEMORY_SCOPE_AGENT); }
__device__ __forceinline__ unsigned xb_add(unsigned* p, unsigned v) { return __hip_atomic_fetch_add(p, v, __ATOMIC_RELAXED, __HIP_MEMORY_SCOPE_AGENT); }
__device__ __forceinline__ unsigned xb_xcc_id() { return (unsigned)__builtin_amdgcn_s_getreg((3 << 11) | 20) & 0xFu; }
#define XB_SPIN(cond, bar) do { unsigned _sp = 0; while (cond) { __builtin_amdgcn_s_sleep(1); \
    if ((++_sp & 255u) == 0u) { if (xb_ld(&(bar)[XB_TMO])) break; if (_sp > XB_SPIN_CAP) { atomicAdd(&(bar)[XB_TMO], 1u); break; } } } } while (0)
struct XcdBarrier { unsigned* bar; unsigned x; volatile LAS unsigned* st; };
__device__ __forceinline__ XcdBarrier xcd_barrier_post(unsigned* bar, volatile LAS unsigned* st) {
    XcdBarrier b; b.bar = bar; b.x = xb_xcc_id(); b.st = st;
    if (threadIdx.x == 0) (void)xb_add(&bar[XB_XCNT(b.x)], 1u);
    return b;
}
__device__ __forceinline__ void xcd_barrier_complete(unsigned* bar, unsigned x, unsigned& nloc, unsigned& nx) {
    const unsigned G = gridDim.x * gridDim.y * gridDim.z;
    unsigned sum, cnt, mine, sp = 0u;
    for (;;) {
        sum = 0u; cnt = 0u; mine = 0u;
#pragma unroll
        for (unsigned j = 0; j < 16; ++j) { const unsigned c = xb_ld(&bar[XB_XCNT(j)]); sum += c; cnt += (c > 0u) ? 1u : 0u; mine = (j == x) ? c : mine; }
        if (sum == G) break;
        __builtin_amdgcn_s_sleep(1);
        if ((++sp & 255u) == 0u) { if (xb_ld(&bar[XB_TMO])) break; if (sp > XB_SPIN_CAP) { atomicAdd(&bar[XB_TMO], 1u); break; } }
    }
    nloc = mine > 0u ? mine : 1u; nx = cnt > 0u ? cnt : 1u;
}
__device__ __forceinline__ void xcd_barrier(const XcdBarrier& b) {
    asm volatile("s_waitcnt vmcnt(0)" ::: "memory");
    __syncthreads();
    if (threadIdx.x == 0) {
        unsigned* bar = b.bar;
        __builtin_amdgcn_s_waitcnt(0);
        unsigned nloc = b.st[0], nx = b.st[1];
        if (nloc == 0u) { xcd_barrier_complete(bar, b.x, nloc, nx); b.st[0] = nloc; b.st[1] = nx; }
        const unsigned old = xb_add(&bar[XB_XSUB(b.x)], 1u);
        const unsigned gen = old / nloc;
        if (old + 1u == (gen + 1u) * nloc) {
            __builtin_amdgcn_fence(__ATOMIC_RELEASE, "agent");
            asm volatile("s_waitcnt vmcnt(0)" ::: "memory");
            const unsigned og = xb_add(&bar[XB_TOP], 1u);
            const unsigned tg = og / nx;
            if (og + 1u == (tg + 1u) * nx) xb_add(&bar[XB_TOPGEN], 1u);
            else XB_SPIN(xb_ld(&bar[XB_TOPGEN]) == tg, bar);
            __builtin_amdgcn_fence(__ATOMIC_ACQUIRE, "agent");
            xb_add(&bar[XB_XGEN(b.x)], 1u);
            asm volatile("s_waitcnt vmcnt(0)" ::: "memory");
        } else {
            XB_SPIN(xb_ld(&bar[XB_XGEN(b.x)]) == gen, bar);
            __builtin_amdgcn_fence(__ATOMIC_ACQUIRE, "agent");
            asm volatile("s_waitcnt vmcnt(0)" ::: "memory");
        }
    }
    __syncthreads();
}

__device__ __forceinline__ float wave_sum(float v) {
#pragma unroll
    for (int o = 1; o < 64; o <<= 1) v += __shfl_xor(v, o);
    return v;
}
__device__ __forceinline__ void p0_transpose_item(const float* W, int K, int N, bf16_t* WT, LAS float* scr, int item, int lane) {
    const int nblk = N / 32, kb = item / nblk, nb = item % nblk, k0 = 64 * kb, n0 = 32 * nb;
#pragma unroll 8
    for (int i = 0; i < 32; ++i) { const int kk = 2 * i + (lane >> 5); scr[kk * 33 + (lane & 31)] = __builtin_nontemporal_load(W + (size_t)(k0 + kk) * N + n0 + (lane & 31)); }
    LDS_WAIT(); asm volatile("" ::: "memory");
    const int c = lane & 7;
#pragma unroll
    for (int j = 0; j < 4; ++j) { const int n = (lane >> 3) + 8 * j; const LAS float* s = scr + (8 * c) * 33 + n;
        u32x4 o; o.x = cvtpk(s[0 * 33], s[1 * 33]); o.y = cvtpk(s[2 * 33], s[3 * 33]); o.z = cvtpk(s[4 * 33], s[5 * 33]); o.w = cvtpk(s[6 * 33], s[7 * 33]);
        *(GAS u32x4*)(WT + (size_t)(n0 + n) * K + k0 + 8 * c) = o; }
    LDS_WAIT(); asm volatile("" ::: "memory");
}

#ifndef DUP_PHASE
#define DUP_PHASE -1
#endif
struct Args { const float* in[16]; float* out; unsigned char* ws; };

__device__ __forceinline__ void p1_rows(const GAS float* x, const GAS float* cx, const GAS float* g, const GAS float* mod, GAS bf16_t* HX, int m0, int m1, int mstep, int lane) {
    for (int m = m0; m < m1; m += mstep) {
        const bool isc = m >= ML;
        const GAS float* xrow = isc ? cx + (size_t)(m - ML) * DM : x + (size_t)m * DM;
        const GAS float* md = mod + (isc ? 4 : (m >> 12)) * 3072;
        const GAS f32x4* xr = (const GAS f32x4*)xrow + lane;
        f32x4 v[4]; float s = 0.f;
#pragma unroll
        for (int j = 0; j < 4; ++j) { v[j] = __builtin_nontemporal_load(xr + 64 * j); s += (v[j].x * v[j].x + v[j].y * v[j].y) + (v[j].z * v[j].z + v[j].w * v[j].w); }
        const float r = __builtin_amdgcn_rsqf(wave_sum(s) * (1.f / DM) + EPS);
        GAS unsigned long long* o8 = (GAS unsigned long long*)(HX + (size_t)m * DM) + lane;
#pragma unroll
        for (int j = 0; j < 4; ++j) {
            const f32x4 gg = *((const GAS f32x4*)g + lane + 64 * j), sh = *((const GAS f32x4*)md + lane + 64 * j), sc = *((const GAS f32x4*)(md + 1024) + lane + 64 * j);
            const f32x4 y = v[j] * r * gg * (sc + 1.0f) + sh;
            o8[64 * j] = (unsigned long long)cvtpk(y.x, y.y) | ((unsigned long long)cvtpk(y.z, y.w) << 32);
        }
    }
}

__global__ void __launch_bounds__(NWAVES * 64, 2) dit_fwd(Args args) {
    extern __shared__ __attribute__((aligned(16))) unsigned char lds_raw[];
    LAS unsigned char* lds = (LAS unsigned char*)lds_raw;
    volatile LAS unsigned* MISC = (volatile LAS unsigned*)(lds + MISC_OFF);
    const int tid = threadIdx.x, lane = tid & 63, wave = __builtin_amdgcn_readfirstlane(tid >> 6);
    const int G = gridDim.x; const int bx = blockIdx.x; const int vcu = (G % 8 == 0) ? (bx % 8) * (G / 8) + bx / 8 : bx;
    unsigned char* ws = args.ws;
    unsigned* ctl = (unsigned*)(ws + WS_CTL);
    for (int u = tid; u < (LDS_BYTES - LDSCTL_OFF) / 4; u += NWAVES * 64) ((LAS unsigned*)(lds + LDSCTL_OFF))[u] = 0u;
    __syncthreads();
    XcdBarrier bar = xcd_barrier_post(ctl + CW_BAR, MISC + 8);

    float* out = args.out;
    const int gw = vcu * NWAVES + wave, NGW = G * NWAVES;

    {
        const float* c_in = args.in[1]; const float* cctx = args.in[3]; const float* w_ada = args.in[4]; const float* b_ada = args.in[5];
        float* MOD = (float*)(ws + WS_MOD); float* ROPE = (float*)(ws + WS_ROPE); float* NWT = (float*)(ws + WS_NW);
        for (int task = vcu; task < 193; task += G) if (task < 192) {
            LAS float* sc = (LAS float*)lds;
            LAS float* red = (LAS float*)(lds + 20480);
            for (int i = tid; i < 5 * 1024; i += NWAVES * 64) { const float cv = (i < 4096) ? c_in[i] : cctx[i - 4096]; sc[i] = cv * fsigmoid(cv); }
            __syncthreads();
            const int l = task / 96, n0 = (task % 96) * 32, col = lane & 31, kh = lane >> 5;
            const float* wp = w_ada + (size_t)l * 1024 * 3072 + n0 + col;
            float a0 = 0.f, a1 = 0.f, a2 = 0.f, a3 = 0.f, a4 = 0.f;
            const int kbase = 128 * wave + 64 * kh;
#pragma unroll 8
            for (int i = 0; i < 64; ++i) { const int k = kbase + i; const float wv = wp[(size_t)k * 3072];
                a0 += sc[k] * wv; a1 += sc[1024 + k] * wv; a2 += sc[2048 + k] * wv; a3 += sc[3072 + k] * wv; a4 += sc[4096 + k] * wv; }
            const int slot = wave * 2 + kh;
            red[(slot * 5 + 0) * 32 + col] = a0; red[(slot * 5 + 1) * 32 + col] = a1; red[(slot * 5 + 2) * 32 + col] = a2; red[(slot * 5 + 3) * 32 + col] = a3; red[(slot * 5 + 4) * 32 + col] = a4;
            __syncthreads();
            if (tid < 160) { const int r = tid >> 5, cc = tid & 31; float sm = 0.f;
                for (int sl = 0; sl < 16; ++sl) sm += red[(sl * 5 + r) * 32 + cc];
                MOD[(size_t)(l * 5 + r) * 3072 + n0 + cc] = sm + b_ada[l * 3072 + n0 + cc]; }
            asm volatile("s_waitcnt vmcnt(0)" ::: "memory"); __syncthreads();
            if (tid == 0) { __builtin_amdgcn_fence(__ATOMIC_RELEASE, "agent"); asm volatile("s_waitcnt vmcnt(0)" ::: "memory"); (void)xb_add(ctl + CW_CNT + 64 * 12, 1u); }
        } else {
            for (int i = tid; i < 64 * 16; i += NWAVES * 64) { const int pos = i >> 4, j = i & 15;
                const float inv = 1.0f / powf(10000.0f, (float)j / 16.0f); const float ang = (float)pos * inv;
                ROPE[2 * i] = cosf(ang); ROPE[2 * i + 1] = sinf(ang); }
            if (tid < 512) { const int l = tid >> 8, w = (tid >> 6) & 3, d = tid & 63; NWT[tid] = args.in[8 + w][l * 64 + d]; }
        }
        const float* w_in = args.in[7]; const float* w_o_a = args.in[13]; const float* w_o_b = args.in[14]; const float* w_out = args.in[15];
        bf16_t* WIN = (bf16_t*)(ws + WS_WIN); bf16_t* WOA = (bf16_t*)(ws + WS_WOA); bf16_t* WOB = (bf16_t*)(ws + WS_WOB); bf16_t* WOUT = (bf16_t*)(ws + WS_WOUT);
        LAS float* scr = (LAS float*)(lds + 32768 + wave * 8704);
        constexpr int I_IN = (DM / 64) * (INC / 32), I_O = (512 / 64) * (DM / 32), I_OUT = (DM / 64) * (DM / 32), I_L = I_IN + 2 * I_O + I_OUT;
        for (int it = gw; it < 2 * I_L; it += NGW) {
            const int l = it / I_L; int r = it % I_L;
            if (r < I_IN) { p0_transpose_item(w_in + (size_t)l * DM * INC, DM, INC, WIN + (size_t)l * INC * DM, scr, r, lane); continue; } r -= I_IN;
            if (r < I_O) { p0_transpose_item(w_o_a + (size_t)l * 512 * DM, 512, DM, WOA + (size_t)l * DM * 512, scr, r, lane); continue; } r -= I_O;
            if (r < I_O) { p0_transpose_item(w_o_b + (size_t)l * 512 * DM, 512, DM, WOB + (size_t)l * DM * 512, scr, r, lane); continue; } r -= I_O;
            p0_transpose_item(w_out + (size_t)l * DM * DM, DM, DM, WOUT + (size_t)l * DM * DM, scr, r, lane);
        }
    }

    enum { K_NONE = 0, K_P1, K_INPROJ, K_ATTN, K_MERGE, K_OUT };
    unsigned* cnt = ctl + CW_CNT;
    for (int step = 0; step < 12; ++step) {
        int kind = K_NONE, layer = step >= 5 ? 1 : 0, i0 = 0, i1 = 1 << 20, single = -1, waitc = -1, sigc = -1, extraL = -1, ctx_extra = -1; unsigned need = 4u;
        int m0 = 0, m1 = 0, mstep = 1;
        bool bar_after = true;
        switch (step) {
            case 0: kind = K_P1; m0 = gw; m1 = MT; mstep = NGW; waitc = 12; need = 192u; break;
            case 1: kind = K_INPROJ; break;
            case 2: kind = K_ATTN; break;
            case 3: kind = K_MERGE; break;
            case 4: kind = K_OUT; break;
            case 5: kind = K_NONE; bar_after = false; break;
            case 6: bar_after = false;
                if (bx >= 64 && bx < 80) { kind = K_MERGE; layer = 0; single = bx - 64; sigc = (bx - 64) >> 2; }
                else { kind = K_INPROJ; if (bx >= 80 && bx < 96) i1 = 2; else if (bx >= 164 && bx < 228) i1 = 4;
                       else if (bx >= 112 && bx < 132) ctx_extra = bx - 112;
                       else if (bx >= 132 && bx < 148) extraL = 4 * G + 64 + (bx - 132);
                       else if (bx >= 148 && bx < 164) extraL = 4 * G + 80 + (bx - 148); }
                break;
            case 7: bar_after = false;
                if (bx >= 64 && bx < 80) { kind = K_INPROJ; i1 = 4; }
                else if (bx >= 80 && bx < 96) { kind = K_OUT; layer = 0; single = bx - 80; waitc = (bx - 80) >> 2; sigc = 4 + ((bx - 80) >> 2); }
                else if (bx >= 164 && bx < 228) { kind = K_P1; m0 = ML + (bx - 164) * 16 + wave; m1 = ML + (bx - 164) * 16 + 16; mstep = NWAVES; waitc = 4 + ((bx - 164) >> 4); sigc = 8 + ((bx - 164) >> 4); }
                break;
            case 8:
                if (bx >= 80 && bx < 96) { kind = K_INPROJ; i0 = 2; i1 = 4; } else if (bx >= 164 && bx < 228) { kind = K_INPROJ; i0 = 4; }
                break;
            case 9: kind = K_ATTN; break;
            case 10: kind = K_MERGE; break;
            default: kind = K_OUT; bar_after = false; break;
        }
        const bool upd = (layer == 0);
        if (waitc >= 0) {
            if (tid == 0) { unsigned sp = 0; while (xb_ld(cnt + 64 * waitc) < need) { __builtin_amdgcn_s_sleep(2); if (++sp > (1u << 22)) break; }
                __builtin_amdgcn_fence(__ATOMIC_ACQUIRE, "agent"); asm volatile("s_waitcnt vmcnt(0)" ::: "memory"); }
            __syncthreads();
        }
        switch (kind) {
        case K_P1: {
            gptr wl = launder(ws); int lane_ = threadIdx.x & 63; asm volatile("" : "+v"(lane_));
            const GAS float* xl = layer == 0 ? (const GAS float*)args.in[0] : (const GAS float*)out;
            const GAS float* cl = layer == 0 ? (const GAS float*)args.in[2] : (const GAS float*)(wl + WS_CTXN);
            p1_rows(xl, cl, (const GAS float*)args.in[6] + layer * DM, (const GAS float*)(wl + WS_MOD) + (size_t)layer * 5 * 3072, (GAS bf16_t*)(wl + WS_HX), m0, m1, mstep, lane_);
        } break;
        case K_INPROJ: {
            InProj p; p.ws = ws; p.layer = layer; p.nM = upd ? 68 : 64; p.nmain = p.nM * 21; p.G = G; p.c = bx; p.i0 = i0; p.i1 = i1; p.single = single; p.extraL = extraL; p.ctx_extra = ctx_extra; p.wcnt = cnt + 64 * (8 + (ctx_extra >= 0 ? ctx_extra / 5 : 0)); p.wneed = 16u;
            pg8::gemm_phase<InProj, DM>(lds, p);
        } break;
        case K_ATTN: {
            char* shm = (char*)lds_raw;
            for (int ug = vcu; ug < 512; ug += G) {
                const int i = ug >> 8, x8 = (ug >> 5) & 7, j = ug & 31;
                const int b = x8 >> 1, kh = x8 & 1, h = kh * 4 + (j >> 3), qb = (j & 7) * 2 + i;
                const size_t qoff = ((size_t)b * SEQ + qb * 256) * QP + h * 64; const size_t koff = (size_t)b * KVR * 128 + kh * 64;
                gptr wl = launder(ws);
                GAS bf16_t* QB = (GAS bf16_t*)(wl + WS_QB); const GAS bf16_t* KB = (const GAS bf16_t*)(wl + WS_KB); const GAS bf16_t* VB = (const GAS bf16_t*)(wl + WS_VB); const GAS bf16_t* SZB = (const GAS bf16_t*)(wl + WS_SZB);
                attn_body::attn_unit<0, 128>(QB + qoff, KB + koff, VB + koff, KVR / 64, 0, (GAS bf16_t*)(wl + WS_YB) + qoff, SZB + qoff, 0, (const GAS float*)nullptr, shm);
            }
            for (int un = vcu; un < 512; un += G) {
                const int i = un >> 8, x8 = (un >> 5) & 7, j = un & 31;
                const int bh = x8 * 4 + (j >> 3), b = bh >> 3, h = bh & 7, qb = (j & 7) * 2 + i;
                int lo = 4 * qb - 4; lo = lo < 0 ? 0 : (lo > 56 ? 56 : lo);
                int hi = 4 * qb - 1; hi = hi < 0 ? 0 : (hi > 56 ? 56 : hi); hi += 7;
                const int nrow = hi - lo + 1;
                const size_t qoff = ((size_t)b * SEQ + qb * 256) * QP + h * 64; const size_t koff = (size_t)b * KVR * 512 + h * 64;
                gptr wl = launder(ws);
                GAS bf16_t* QA = (GAS bf16_t*)(wl + WS_QA); const GAS bf16_t* KA = (const GAS bf16_t*)(wl + WS_KA); const GAS bf16_t* VA = (const GAS bf16_t*)(wl + WS_VA); const GAS bf16_t* SZA = (const GAS bf16_t*)(wl + WS_SZA);
                attn_body::attn_unit<1, 512>(QA + qoff, KA + koff, VA + koff, 4 + nrow, lo, (GAS bf16_t*)(wl + WS_YA) + qoff, SZA + qoff, 4 * qb, (const GAS float*)args.in[12] + ((size_t)layer * 8 + h) * 15 * 31, shm);
            }
            if (upd) for (int uc = vcu; uc < 256; uc += G) if ((uc & 7) == 0 || (uc & 7) == 7) {
                const int id = (uc >> 3) * 2 + ((uc & 7) == 7 ? 1 : 0), br = id >> 5, bh = id & 31, b = bh >> 3, h = bh & 7;
                const size_t qoff = ((size_t)ML + b * CTXL) * QP + h * 64, yoff = ((size_t)b * CTXL) * QP + h * 64;
                gptr wl = launder(ws);
                if (br == 0) { const size_t koff = (size_t)b * KVR * 512 + h * 64;
                    GAS bf16_t* QA = (GAS bf16_t*)(wl + WS_QA); const GAS bf16_t* KA = (const GAS bf16_t*)(wl + WS_KA); const GAS bf16_t* VA = (const GAS bf16_t*)(wl + WS_VA); const GAS bf16_t* SZA = (const GAS bf16_t*)(wl + WS_SZA);
                    attn_body::attn_unit<0, 512>(QA + qoff, KA + koff, VA + koff, 4, 0, (GAS bf16_t*)(wl + WS_YCA) + yoff, SZA + qoff, 0, (const GAS float*)nullptr, shm); }
                else { const size_t koff = (size_t)b * KVR * 128 + (h >> 2) * 64;
                    GAS bf16_t* QB = (GAS bf16_t*)(wl + WS_QB); const GAS bf16_t* KB = (const GAS bf16_t*)(wl + WS_KB); const GAS bf16_t* VB = (const GAS bf16_t*)(wl + WS_VB); const GAS bf16_t* SZB = (const GAS bf16_t*)(wl + WS_SZB);
                    attn_body::attn_unit<0, 128>(QB + qoff, KB + koff, VB + koff, 4, 0, (GAS bf16_t*)(wl + WS_YCB) + yoff, SZB + qoff, 0, (const GAS float*)nullptr, shm); }
            }
        } break;
        case K_MERGE: {
            MergeProj p; p.ws = ws; p.layer = layer; p.G = G; p.c = bx; p.single = single;
            pg8::gemm_phase<MergeProj, 512>(lds, p);
        } break;
        case K_OUT: {
            OutProj p; p.ws = ws; p.layer = layer; p.xin = layer == 0 ? (const GAS float*)args.in[0] : (const GAS float*)out; p.xout = (GAS float*)out; p.cin = (const GAS float*)args.in[2]; p.G = G; p.c = bx; p.single = single;
            p.fuse = (step == 4) ? 1 : 0; p.rmode = single >= 0 ? 0 : (layer == 0 ? 1 : 2); p.ng = (const GAS float*)args.in[6] + DM;
            pg8::gemm_phase<OutProj, DM>(lds, p);
        } break;
        default: break;
        }
        if (sigc >= 0) {
            asm volatile("s_waitcnt vmcnt(0)" ::: "memory"); __syncthreads();
            if (tid == 0) { __builtin_amdgcn_fence(__ATOMIC_RELEASE, "agent"); asm volatile("s_waitcnt vmcnt(0)" ::: "memory"); (void)xb_add(cnt + 64 * sigc, 1u); }
        }
        if (bar_after) xcd_barrier(bar);
    }
}

extern "C" void kernel_launch(void* const* d_in, const int* in_sizes, int n_in, void* d_out, int out_size, void* d_ws, size_t ws_size, hipStream_t stream) {
    static int grid = 0;
    if (grid == 0) {
        if (n_in != 16 || out_size != ML * DM || ws_size < WS_USED) { fprintf(stderr, "kernel_launch: unexpected problem (n_in %d out %d ws %zu)\n", n_in, out_size, ws_size); grid = -1; return; }
        int dev = 0, cus = 0, per_cu = 0;
        if (hipGetDevice(&dev) != hipSuccess || hipDeviceGetAttribute(&cus, hipDeviceAttributeMultiprocessorCount, dev) != hipSuccess) { grid = -1; return; }
        if (hipFuncSetAttribute((const void*)dit_fwd, hipFuncAttributeMaxDynamicSharedMemorySize, LDS_BYTES) != hipSuccess) { fprintf(stderr, "kernel_launch: hipFuncSetAttribute failed\n"); grid = -1; return; }
        if (hipOccupancyMaxActiveBlocksPerMultiprocessor(&per_cu, (const void*)dit_fwd, NWAVES * 64, LDS_BYTES) != hipSuccess || per_cu < 1) { fprintf(stderr, "kernel_launch: occupancy query says %d\n", per_cu); per_cu = 1; }
        (void)hipGetLastError();
        grid = cus;
        if (grid != 256) fprintf(stderr, "kernel_launch: %d CUs; the static unit maps assume 256\n", grid);
    }
    if (grid < 0) return;
    (void)hipMemsetAsync((char*)d_ws + WS_CTL, 0, CTL_ZERO_BYTES, stream);
    Args a{};
    for (int i = 0; i < 16; ++i) a.in[i] = (const float*)d_in[i];
    a.out = (float*)d_out; a.ws = (unsigned char*)d_ws;
    hipLaunchKernelGGL(dit_fwd, dim3(grid), dim3(NWAVES * 64), LDS_BYTES, stream, a);
}
```
